# Optimizing an MI355X kernel written in HIP

```python
import jax, jax.numpy as jnp
from jax import lax
import numpy as np

D_MODEL = 1024
BATCH = 2
SEQ = 8192
DEPTH = 4

GLA_HEADS = 4
GLA_HEAD_K = 64
GLA_HEAD_V = 128
GLA_DK = GLA_HEADS * GLA_HEAD_K
GLA_DV = GLA_HEADS * GLA_HEAD_V
GLA_GATE_RANK = 16
GLA_GATE_TAU = 16.0
GLA_CHUNK = 64
GLA_NORM_EPS = 1e-5
RWKV_HEADS = 8
RWKV_HEAD = 64
RWKV_DIM = RWKV_HEADS * RWKV_HEAD
RWKV_DECAY_RANK = 64
RWKV_ICLR_RANK = 64
RWKV_GATE_RANK = 128
RWKV_GN_EPS = 64e-5
ATT_HEADS = 8
ATT_HEAD = 64
ATT_DIM = ATT_HEADS * ATT_HEAD
DILATED_PATTERNS = ((128, 1), (512, 4), (2048, 16))
ATT_BLOCK = 128
N_BRANCH = 3
FFN_HIDDEN = -(-8 * D_MODEL // (3 * 256)) * 256
LN_EPS = 1e-5
DEEPNORM_ALPHA = (2 * DEPTH) ** 0.25
DEEPNORM_BETA = (8 * DEPTH) ** -0.25

GLA_WIDTHS = (GLA_DK, GLA_DK, GLA_DV, GLA_GATE_RANK, GLA_DV)
RWKV_WIDTHS = (RWKV_DIM, RWKV_DIM, RWKV_DIM, RWKV_DECAY_RANK, RWKV_ICLR_RANK, RWKV_GATE_RANK)
ATT_WIDTHS = (ATT_DIM, ATT_DIM, ATT_DIM)
RWKV_IN = sum(RWKV_WIDTHS)
GROUP_WIDTHS = (sum(GLA_WIDTHS), RWKV_IN, sum(ATT_WIDTHS), N_BRANCH * D_MODEL)
D_IN = sum(GROUP_WIDTHS)

kernel_name = "hybrid_gla_rwkv7_dilated_deepnorm_adaln"


def _split(t, widths):
    return jnp.split(t, np.cumsum(widths)[:-1].tolist(), axis=-1)


def _split_heads(t, n_heads):
    b, s, _ = t.shape
    return t.reshape(b, s, n_heads, -1).transpose(0, 2, 1, 3)


def _merge_heads(t):
    b, h, s, d = t.shape
    return t.transpose(0, 2, 1, 3).reshape(b, s, h * d)


def layer_norm(x, g, b):
    xf = x.astype(jnp.float32)
    mu = jnp.mean(xf, -1, keepdims=True)
    var = jnp.mean(jnp.square(xf - mu), -1, keepdims=True)
    return ((xf - mu) * lax.rsqrt(var + LN_EPS) * g + b).astype(x.dtype)


def token_shift(p, mu):
    prev = jnp.pad(p, ((0, 0), (1, 0), (0, 0)))[:, :-1]
    return p + (prev - p) * mu


def alibi_slopes(n_heads):
    return 2.0 ** (-8.0 * jnp.arange(1, n_heads + 1, dtype=jnp.float32) / n_heads)


def gla_mixer(q, k, v, a_lo, og, w_alpha, b_alpha, norm_g):
    f32 = jnp.float32
    b_, s_, _ = q.shape
    log_a = jax.nn.log_sigmoid((a_lo @ w_alpha + b_alpha).astype(f32)) / GLA_GATE_TAU
    nc = s_ // GLA_CHUNK

    def chunk(t):
        t = _split_heads(t.astype(f32), GLA_HEADS)
        return t.reshape(b_, GLA_HEADS, nc, GLA_CHUNK, t.shape[-1])

    q, k, v, log_a = chunk(q) * GLA_HEAD_K ** -0.5, chunk(k), chunk(v), chunk(log_a)
    cum = jnp.cumsum(log_a, axis=3)
    cum_last = cum[:, :, :, -1:, :]
    q_e = q * jnp.exp(cum)
    k_e = k * jnp.exp(-cum)
    causal = jnp.tril(jnp.ones((GLA_CHUNK, GLA_CHUNK), bool))
    att = jnp.where(causal, jnp.einsum('bhnck,bhnsk->bhncs', q_e, k_e), 0.0)
    o = jnp.einsum('bhncs,bhnsv->bhncv', att, v)
    d_state = jnp.einsum('bhnck,bhncv->bhnkv', k * jnp.exp(cum_last - cum), v)
    decay = jnp.exp(cum_last[:, :, :, 0, :])

    def step(state, inp):
        dec, ds = inp
        return dec[..., None] * state + ds, state

    state0 = jnp.zeros((b_, GLA_HEADS, GLA_HEAD_K, GLA_HEAD_V), f32)
    _, s_prev = lax.scan(step, state0, (jnp.moveaxis(decay, 2, 0), jnp.moveaxis(d_state, 2, 0)))
    s_prev = jnp.moveaxis(s_prev, 0, 2)
    o = o + jnp.einsum('bhnck,bhnkv->bhncv', q_e, s_prev)
    o = o.reshape(b_, GLA_HEADS, s_, GLA_HEAD_V)
    o = o * lax.rsqrt(jnp.mean(o * o, -1, keepdims=True) + GLA_NORM_EPS) * norm_g
    return _merge_heads(o) * jax.nn.silu(og.astype(f32))


def rwkv7_mixer(r, k, v, w_lo, a_lo, g_lo, w0, w_up, a0, a_up, g_up, k_k, k_a, r_k, gn_g, gn_b):
    f32 = jnp.float32
    b_, s_, _ = r.shape
    r, k, v, w_lo, a_lo, g_lo = (t.astype(f32) for t in (r, k, v, w_lo, a_lo, g_lo))
    w_log = -jax.nn.softplus(-(w0 + jnp.tanh(w_lo) @ w_up)) - 0.5
    decay = jnp.exp(-jnp.exp(w_log))
    a = jax.nn.sigmoid(a0 + a_lo @ a_up)
    g = jax.nn.sigmoid(g_lo) @ g_up
    kk = k * k_k
    k = k * (1.0 + (a - 1.0) * k_a)
    hd = lambda t: t.reshape(b_, s_, RWKV_HEADS, RWKV_HEAD)
    r, k, v, kk, a, decay = map(hd, (r, k, v, kk, a, decay))
    kk = kk / jnp.maximum(jnp.sqrt(jnp.sum(kk * kk, -1, keepdims=True)), 1e-12)

    def step(state, inp):
        r_t, w_t, k_t, v_t, kk_t, b_t = inp
        sa = jnp.einsum('bhvk,bhk->bhv', state, -kk_t)
        state = state * w_t[:, :, None, :] + sa[..., None] * b_t[:, :, None, :] + v_t[..., None] * k_t[:, :, None, :]
        return state, jnp.einsum('bhvk,bhk->bhv', state, r_t)

    tm = lambda t: jnp.moveaxis(t, 1, 0)
    state0 = jnp.zeros((b_, RWKV_HEADS, RWKV_HEAD, RWKV_HEAD), f32)
    _, y = lax.scan(step, state0, (tm(r), tm(decay), tm(k), tm(v), tm(kk), tm(kk * a)))
    y = jnp.moveaxis(y, 0, 1)
    mu = jnp.mean(y, -1, keepdims=True)
    var = jnp.mean(jnp.square(y - mu), -1, keepdims=True)
    y = (y - mu) * lax.rsqrt(var + RWKV_GN_EPS) * gn_g.reshape(RWKV_HEADS, RWKV_HEAD) + gn_b.reshape(RWKV_HEADS, RWKV_HEAD)
    y = y + jnp.sum(r * k * r_k, -1, keepdims=True) * v
    return y.reshape(b_, s_, RWKV_DIM) * g


def dilated_pattern(q, k, v, window, dilation):
    b_, h_, s_, dh = q.shape
    span = window // dilation
    unit = dilation * ATT_BLOCK
    s_pad = -(-s_ // unit) * unit
    n_sub = s_pad // dilation
    nb = n_sub // ATT_BLOCK

    def to_blocks(t):
        t = jnp.pad(t, ((0, 0), (0, 0), (0, s_pad - s_), (0, 0)))
        t = t.reshape(b_, h_, n_sub, dilation, dh).transpose(0, 1, 3, 2, 4)
        return t.reshape(b_, h_, dilation, nb, ATT_BLOCK, dh)

    def with_prev(t):
        prev = jnp.pad(t, ((0, 0), (0, 0), (0, 0), (1, 0), (0, 0), (0, 0)))[:, :, :, :-1]
        return jnp.concatenate([prev, t], axis=4)

    qb, kb, vb = to_blocks(q), to_blocks(k), to_blocks(v)
    kc, vc = with_prev(kb), with_prev(vb)
    s = jnp.einsum('bhrnqd,bhrnkd->bhrnqk', qb, kc) * dh ** -0.5
    key_idx = jnp.arange(2 * ATT_BLOCK)
    steps = jnp.arange(ATT_BLOCK)[:, None] + ATT_BLOCK - key_idx[None, :]
    blk = jnp.arange(nb)[:, None, None]
    valid = (steps >= 0) & (steps <= span) & ((blk > 0) | (key_idx >= ATT_BLOCK)[None, None, :])
    bias = -alibi_slopes(h_)[:, None, None, None, None] * (steps * dilation).astype(jnp.float32)
    s = jnp.where(valid, s + bias, -jnp.inf)
    m = jnp.max(s, -1, keepdims=True)
    p = jnp.exp(s - m)
    den = jnp.sum(p, -1, keepdims=True)
    o = jnp.einsum('bhrnqk,bhrnkd->bhrnqd', p, vc) / den
    lse = (m + jnp.log(den))[..., 0]

    def from_blocks(t):
        tail = t.shape[5:]
        t = t.reshape(b_, h_, dilation, n_sub, *tail)
        t = jnp.moveaxis(t, 2, 3).reshape(b_, h_, s_pad, *tail)
        return t[:, :, :s_]

    return from_blocks(o), from_blocks(lse)


def dilated_attention(q, k, v):
    q, k, v = (_split_heads(t.astype(jnp.float32), ATT_HEADS) for t in (q, k, v))
    res = [dilated_pattern(q, k, v, w, d) for (w, d) in DILATED_PATTERNS]
    outs = jnp.stack([o for o, _ in res])
    lses = jnp.stack([l for _, l in res])
    wts = jax.nn.softmax(lses, axis=0)
    return _merge_heads(jnp.sum(wts[..., None] * outs, axis=0))


def hybrid_mixer(u, w_in, gla_w_alpha, gla_b_alpha, gla_norm_g, rwkv_mu, rwkv_w0, rwkv_w_up,
                 rwkv_a0, rwkv_a_up, rwkv_g_up, rwkv_k_k, rwkv_k_a, rwkv_r_k, rwkv_gn_g, rwkv_gn_b,
                 w_branch, w_out):
    b_, s_, _ = u.shape
    p = u @ w_in
    gla_p, rwkv_p, att_p, gate_p = _split(p, GROUP_WIDTHS)
    gq, gk, gv, ga, gg = _split(gla_p, GLA_WIDTHS)
    rr, rk, rv, rw, ra, rg = _split(token_shift(rwkv_p, rwkv_mu), RWKV_WIDTHS)
    aq, ak, av = _split(att_p, ATT_WIDTHS)
    o_a = gla_mixer(gq, gk, gv, ga, gg, gla_w_alpha, gla_b_alpha, gla_norm_g)
    o_b = rwkv7_mixer(rr, rk, rv, rw, ra, rg, rwkv_w0, rwkv_w_up, rwkv_a0, rwkv_a_up, rwkv_g_up,
                      rwkv_k_k, rwkv_k_a, rwkv_r_k, rwkv_gn_g, rwkv_gn_b)
    o_c = dilated_attention(aq, ak, av)
    branches = jnp.stack([o_a, o_b, o_c], axis=2).astype(u.dtype)
    proj = jnp.einsum('bsnc,ncd->bsnd', branches, w_branch)
    gates = jax.nn.sigmoid(gate_p.astype(jnp.float32)).reshape(b_, s_, N_BRANCH, D_MODEL)
    merged = jnp.sum(gates * proj, axis=2).astype(u.dtype)
    return merged @ w_out


def swiglu(u, w1, w2):
    gate, up = jnp.split(u @ w1, 2, axis=-1)
    return (jax.nn.silu(gate) * up) @ w2


def setup_inputs(seed: int = 0) -> dict:
    key = jax.random.key(seed)
    ks = iter(jax.random.split(key, 40))
    f32 = jnp.float32
    L = DEPTH
    nrm = lambda shape, scale: jax.random.normal(next(ks), shape, f32) * scale
    uni = lambda shape, lo, hi: jax.random.uniform(next(ks), shape, f32, lo, hi)
    return {
        "x": nrm((BATCH, SEQ, D_MODEL), 1.0),
        "c": nrm((BATCH, D_MODEL), 1.0),
        "w_ada": nrm((L, D_MODEL, 6 * D_MODEL), 0.1 * D_MODEL ** -0.5),
        "b_ada": nrm((L, 6 * D_MODEL), 0.01),
        "w_in": nrm((L, D_MODEL, D_IN), D_MODEL ** -0.5),
        "gla_w_alpha": nrm((L, GLA_GATE_RANK, GLA_DK), GLA_GATE_RANK ** -0.5),
        "gla_b_alpha": nrm((L, GLA_DK), 0.1),
        "gla_norm_g": 1.0 + nrm((L, GLA_HEAD_V), 0.02),
        "rwkv_mu": uni((L, RWKV_IN), 0.0, 1.0),
        "rwkv_w0": uni((L, RWKV_DIM), -6.0, 1.0),
        "rwkv_w_up": nrm((L, RWKV_DECAY_RANK, RWKV_DIM), 0.1 * RWKV_DECAY_RANK ** -0.5),
        "rwkv_a0": nrm((L, RWKV_DIM), 0.1),
        "rwkv_a_up": nrm((L, RWKV_ICLR_RANK, RWKV_DIM), 0.1 * RWKV_ICLR_RANK ** -0.5),
        "rwkv_g_up": nrm((L, RWKV_GATE_RANK, RWKV_DIM), RWKV_GATE_RANK ** -0.5),
        "rwkv_k_k": 0.85 + nrm((L, RWKV_DIM), 0.02),
        "rwkv_k_a": 1.0 + nrm((L, RWKV_DIM), 0.02),
        "rwkv_r_k": nrm((L, RWKV_HEADS, RWKV_HEAD), 0.1),
        "rwkv_gn_g": 1.0 + nrm((L, RWKV_DIM), 0.02),
        "rwkv_gn_b": nrm((L, RWKV_DIM), 0.01),
        "w_branch": nrm((L, N_BRANCH, ATT_DIM, D_MODEL), ATT_DIM ** -0.5),
        "w_out": nrm((L, D_MODEL, D_MODEL), DEEPNORM_BETA * D_MODEL ** -0.5),
        "ln1_g": 1.0 + nrm((L, D_MODEL), 0.02),
        "ln1_b": nrm((L, D_MODEL), 0.01),
        "ffn_w1": nrm((L, D_MODEL, 2 * FFN_HIDDEN), D_MODEL ** -0.5),
        "ffn_w2": nrm((L, FFN_HIDDEN, D_MODEL), DEEPNORM_BETA * FFN_HIDDEN ** -0.5),
        "ln2_g": 1.0 + nrm((L, D_MODEL), 0.02),
        "ln2_b": nrm((L, D_MODEL), 0.01),
    }


def reference(x, c, w_ada, b_ada, w_in, gla_w_alpha, gla_b_alpha, gla_norm_g, rwkv_mu, rwkv_w0,
              rwkv_w_up, rwkv_a0, rwkv_a_up, rwkv_g_up, rwkv_k_k, rwkv_k_a, rwkv_r_k, rwkv_gn_g,
              rwkv_gn_b, w_branch, w_out, ln1_g, ln1_b, ffn_w1, ffn_w2, ln2_g, ln2_b):
    for l in range(DEPTH):
        mod = jax.nn.silu(c) @ w_ada[l] + b_ada[l]
        sh1, sc1, g1, sh2, sc2, g2 = jnp.split(mod[:, None, :], 6, axis=-1)
        u = x * (1.0 + sc1) + sh1
        h = hybrid_mixer(u, w_in[l], gla_w_alpha[l], gla_b_alpha[l], gla_norm_g[l], rwkv_mu[l],
                         rwkv_w0[l], rwkv_w_up[l], rwkv_a0[l], rwkv_a_up[l], rwkv_g_up[l],
                         rwkv_k_k[l], rwkv_k_a[l], rwkv_r_k[l], rwkv_gn_g[l], rwkv_gn_b[l],
                         w_branch[l], w_out[l])
        x = layer_norm(DEEPNORM_ALPHA * x + (1.0 + g1) * h, ln1_g[l], ln1_b[l])
        u = x * (1.0 + sc2) + sh2
        h = swiglu(u, ffn_w1[l], ffn_w2[l])
        x = layer_norm(DEEPNORM_ALPHA * x + (1.0 + g2) * h, ln2_g[l], ln2_b[l])
    return x
```

```cpp
#ifndef MK_ONE_LAUNCH
#define MK_ONE_LAUNCH 1
#endif
#include <hip/hip_runtime.h>
#include <cstdio>
#include <cstdint>
namespace pg8 {
#define PG8_LAS __attribute__((address_space(3)))
typedef unsigned short bf16_t;
typedef short bf16x8 __attribute__((ext_vector_type(8)));
typedef float f32x4 __attribute__((ext_vector_type(4)));
typedef unsigned u32x4 __attribute__((ext_vector_type(4)));
constexpr int BM = 256, BK = 64, HALF = 128, HTB = HALF * BK * 2  , STAGE_BYTES = 8 * HTB, NXCD = 8, WGM = 8;

__host__ __device__ __forceinline__ int lds_byte(int r, int c) { const int st = (r >> 4) * 2 + (c >> 5), rr = r & 15, cc = c & 31, ob = rr * 64 + cc * 2; return st * 1024 + (ob ^ (((ob >> 9) & 1) << 5)); }
__host__ __device__ __forceinline__ void stage_rc(int b, int& R, int& C) { const int st = b / 1024, sb = b % 1024, swz = sb ^ (((sb >> 9) & 1) << 5); R = (st >> 1) * 16 + swz / 64; C = (st & 1) * 32 + (swz % 64) / 2; }
__host__ __device__ __forceinline__ int perm32(int rho) { const int n = rho >> 4, i = rho & 15; return 8 * (i >> 2) + 4 * n + (i & 3); }

struct Unit { int pm, pn; };
struct Gemm { const bf16_t* A; const bf16_t* Bt; int M, N, K; };

struct StaticOrder {
    int nM, nN, nwg, G, c;
    __host__ __device__ void init(int M, int N, int G_, int c_) { nM = M / BM; nN = N / BM; nwg = nM * nN; G = G_; c = c_; }
    __host__ __device__ bool next(int i, Unit& u) const {
        const long L = (long)i * G + c; if (L >= nwg) return false;
        int wgid = (int)L; { const int q = nwg / NXCD, r = nwg % NXCD, xcd = wgid % NXCD, off = wgid / NXCD; wgid = (xcd < r ? xcd * (q + 1) : r * (q + 1) + (xcd - r) * q) + off; }
        const int nig = WGM * nN, gid = wgid / nig, fm = gid * WGM, gsz = (nM - fm) < WGM ? (nM - fm) : WGM;
        u.pm = fm + ((wgid % nig) % gsz); u.pn = (wgid % nig) / gsz; return true;
    }
    __device__ __forceinline__ void a_ready(const Unit&) const {}
    __device__ __forceinline__ void done(const Unit&) const {}
};

__device__ __forceinline__ unsigned cvt_pk_bf16(float lo, float hi) { unsigned r; asm volatile("v_cvt_pk_bf16_f32 %0, %1, %2" : "=v"(r) : "v"(lo), "v"(hi)); return r; }
typedef float f32x2 __attribute__((ext_vector_type(2)));
__device__ __forceinline__ f32x2 gelu_pk(f32x2 v) {
    const f32x2 av = __builtin_elementwise_abs(v), d = av * 0.2316418882f + 1.0f;
    f32x2 t; t.x = __builtin_amdgcn_rcpf(d.x); t.y = __builtin_amdgcn_rcpf(d.y);
    f32x2 q = t * 0.5307027145f + (-0.7265760135f); q = q * t + 0.7107068705f; q = q * t + (-0.142248368f); q = q * t + 0.127414796f; q = q * t;
    const f32x2 s = (v * v) * (-0.72134752044f);
    f32x2 e; e.x = __builtin_amdgcn_exp2f(s.x); e.y = __builtin_amdgcn_exp2f(s.y);
    const f32x2 m = v * (q * e), r = v - m;
    f32x2 o; o.x = v.x < 0.f ? m.x : r.x; o.y = v.y < 0.f ? m.y : r.y; return o;
}

template <int ACT  > struct EpiBf16 {
    static constexpr bool PERM = true, AFTER_DRAIN = false; static_assert(ACT == 0 || ACT == 1, "EpiBf16: ACT is 0 (none) or 1 (gelu_pk)");
    bf16_t* O; int ldc; const float* bias; int split_cols; size_t split_stride; float scale0;
    __device__ __forceinline__ void operator()(const f32x4 (&acc)[2][2][4][2], const Unit& u, int wr, int wc, int fr, int fq) const {
        const int row0 = u.pm * BM + wr * 64 + fr; int colt = u.pn * BM; bf16_t* base = O;
        float sc = 1.f; if (split_cols) { const int t = colt / split_cols; base += (size_t)t * split_stride; colt -= t * split_cols; if (t == 0) sc = scale0; }
        const int col0 = colt + wc * 32 + 8 * fq, bcol0 = u.pn * BM + wc * 32 + 8 * fq;
        f32x4 bv[2][2];
#pragma unroll
        for (int bj = 0; bj < 2; ++bj)
#pragma unroll
            for (int n = 0; n < 2; ++n) bv[bj][n] = bias ? *(const f32x4*)(bias + bcol0 + bj * HALF + 4 * n) : (f32x4){0.f, 0.f, 0.f, 0.f};
#pragma unroll
        for (int ai = 0; ai < 2; ++ai)
#pragma unroll
            for (int m = 0; m < 4; ++m) { bf16_t* rowp = base + (size_t)(row0 + ai * HALF + m * 16) * ldc + col0;
#pragma unroll
                for (int bj = 0; bj < 2; ++bj) { f32x4 v0 = acc[ai][bj][m][0] + bv[bj][0], v1 = acc[ai][bj][m][1] + bv[bj][1];
                    if (ACT == 1) { f32x2 a = gelu_pk((f32x2){v0[0], v0[1]}), b = gelu_pk((f32x2){v0[2], v0[3]}), c = gelu_pk((f32x2){v1[0], v1[1]}), d = gelu_pk((f32x2){v1[2], v1[3]});
                        v0 = (f32x4){a.x, a.y, b.x, b.y}; v1 = (f32x4){c.x, c.y, d.x, d.y}; }
                    v0 = v0 * sc; v1 = v1 * sc; u32x4 w; w.x = cvt_pk_bf16(v0[0], v0[1]); w.y = cvt_pk_bf16(v0[2], v0[3]); w.z = cvt_pk_bf16(v1[0], v1[1]); w.w = cvt_pk_bf16(v1[2], v1[3]);
                    *(u32x4*)(rowp + bj * HALF) = w; } }
    }
};

struct PanelStats {
    unsigned* xbuf;
    unsigned* cnt;
    unsigned* tmo;
    int ntn; float eps;
    unsigned code;
    __device__ __forceinline__ bool run(const f32x4 (&v)[2][2][4][2], const Unit& u, int wr, int wc, int fr, int fq, PG8_LAS unsigned char* lds, int wid, int lane) const {
        typedef float f32x2v __attribute__((ext_vector_type(2)));
        PG8_LAS f32x2v* P = (PG8_LAS f32x2v*)lds;
        PG8_LAS f32x2v* S = (PG8_LAS f32x2v*)(lds + 8192);
        PG8_LAS unsigned* flag = (PG8_LAS unsigned*)(lds + 8192 + 2048);
#pragma unroll
        for (int ai = 0; ai < 2; ++ai)
#pragma unroll
            for (int m = 0; m < 4; ++m) {
                float s = 0.f;
#pragma unroll
                for (int bj = 0; bj < 2; ++bj)
#pragma unroll
                    for (int n = 0; n < 2; ++n) { const f32x4 x = v[ai][bj][m][n]; s += (x[0] + x[1]) + (x[2] + x[3]); }
                s += __shfl_xor(s, 16); s += __shfl_xor(s, 32);
                const float mw = s * (1.0f / 64.0f); float q = 0.f;
#pragma unroll
                for (int bj = 0; bj < 2; ++bj)
#pragma unroll
                    for (int n = 0; n < 2; ++n) { const f32x4 d = v[ai][bj][m][n] - mw; q += (d[0] * d[0] + d[1] * d[1]) + (d[2] * d[2] + d[3] * d[3]); }
                q += __shfl_xor(q, 16); q += __shfl_xor(q, 32);
                if (fq == 0) P[(ai * HALF + wr * 64 + m * 16 + fr) * 4 + wc] = (f32x2v){mw, q};
            }
        asm volatile("s_waitcnt lgkmcnt(0)" ::: "memory"); __builtin_amdgcn_s_barrier(); asm volatile("" ::: "memory");
#if defined(BROKEN_EXCHANGE_NO_WAIT)
#warning BROKEN CONTROL BUILD: the row-statistics exchange does not wait; results are wrong by design
        if (blockIdx.x >= 64) { const long long t0_ = clock64(); while (clock64() - t0_ < 60000) __builtin_amdgcn_s_sleep(8); }
#endif
        const int row = wid * 32 + (lane & 31);
        if (lane < 32) {
            const f32x2v a = P[row * 4 + 0], b = P[row * 4 + 1], c = P[row * 4 + 2], d = P[row * 4 + 3];
            const float mt = (a.x + b.x + c.x + d.x) * 0.25f;
            const float da = a.x - mt, db = b.x - mt, dc = c.x - mt, dd = d.x - mt;
            const float m2 = (a.y + b.y) + (c.y + d.y) + 64.0f * ((da * da + db * db) + (dc * dc + dd * dd));
            unsigned long long* slot = (unsigned long long*)xbuf + ((size_t)(u.pm * BM + row) * 4 + u.pn);
            __hip_atomic_store(slot, ((unsigned long long)__float_as_uint(m2) << 32) | __float_as_uint(mt), __ATOMIC_RELAXED, __HIP_MEMORY_SCOPE_AGENT);
        }
        asm volatile("s_waitcnt vmcnt(0)" ::: "memory");
        if (lane == 0) __hip_atomic_fetch_add(cnt + 64 * u.pm, 1u, __ATOMIC_RELAXED, __HIP_MEMORY_SCOPE_AGENT);
        if (wid == 0) {
            bool dead = false; const unsigned long long t0 = __builtin_amdgcn_s_memrealtime(); const unsigned want = 8u * (unsigned)ntn;
            for (;;) {
#if defined(BROKEN_EXCHANGE_NO_WAIT)
                break;
#endif
                if ((unsigned)__builtin_amdgcn_readfirstlane(__hip_atomic_load(cnt + 64 * u.pm, __ATOMIC_RELAXED, __HIP_MEMORY_SCOPE_AGENT)) >= want) break;
                if (__builtin_amdgcn_s_memrealtime() - t0 > 2000000ull) {
                    if (lane == 0) { unsigned expect = 0u; __hip_atomic_compare_exchange_strong(tmo + 1, &expect, code | (unsigned)(u.pm & 0xff), __ATOMIC_RELAXED, __ATOMIC_RELAXED, __HIP_MEMORY_SCOPE_AGENT);
                                     __hip_atomic_store(tmo, 1u, __ATOMIC_RELAXED, __HIP_MEMORY_SCOPE_AGENT); }
                    dead = true; break; }
                __builtin_amdgcn_s_sleep(2);
            }
            __builtin_amdgcn_fence(__ATOMIC_ACQUIRE, "agent");
            if (lane == 0) flag[0] = dead ? 1u : 0u;
        }
        asm volatile("s_waitcnt vmcnt(0) lgkmcnt(0)" ::: "memory"); __builtin_amdgcn_s_barrier(); asm volatile("" ::: "memory");
        const bool bad = flag[0] != 0u;
        if (lane < 32) {
            const unsigned long long* slot = (const unsigned long long*)xbuf + (size_t)(u.pm * BM + row) * 4; float mt[4], m2[4]; float ms = 0.f;
#pragma unroll
            for (int t = 0; t < 4; ++t) { if (t < ntn) { const unsigned long long w = __hip_atomic_load(slot + t, __ATOMIC_RELAXED, __HIP_MEMORY_SCOPE_AGENT); mt[t] = __uint_as_float((unsigned)w); m2[t] = __uint_as_float((unsigned)(w >> 32)); } else { mt[t] = 0.f; m2[t] = 0.f; } ms += mt[t]; }
            const float mean = ms / (float)ntn; float q = 0.f;
#pragma unroll
            for (int t = 0; t < 4; ++t) if (t < ntn) { const float dm = mt[t] - mean; q += m2[t] + 256.0f * dm * dm; }
            S[row] = (f32x2v){mean, 1.0f / sqrtf(q / (256.0f * (float)ntn) + eps)};
        }
        asm volatile("s_waitcnt lgkmcnt(0)" ::: "memory"); __builtin_amdgcn_s_barrier(); asm volatile("" ::: "memory");
        return bad;
    }
};
struct EpiLnRes {
    static constexpr bool PERM = false, AFTER_DRAIN = true;
    const float* base; float* out; int ldc; const float* bias; PanelStats st; unsigned poison;
    __device__ __forceinline__ void fused(f32x4 (&acc)[2][2][4][2], const Unit& u, int wr, int wc, int fr, int fq, PG8_LAS unsigned char* lds, int wid, int lane) const {
        typedef float f32x2v __attribute__((ext_vector_type(2)));
        const PG8_LAS f32x2v* S = (const PG8_LAS f32x2v*)(lds + 8192);
        const int col0 = u.pn * BM + wc * 32 + 4 * fq;
#pragma unroll
        for (int bj = 0; bj < 2; ++bj)
#pragma unroll
            for (int n = 0; n < 2; ++n) { const f32x4 bv = bias ? *(const f32x4*)(bias + col0 + bj * HALF + n * 16) : (f32x4){0.f, 0.f, 0.f, 0.f};
#pragma unroll
                for (int ai = 0; ai < 2; ++ai)
#pragma unroll
                    for (int m = 0; m < 4; ++m) acc[ai][bj][m][n] += bv; }
        f32x4 pre[4][2][2];
#pragma unroll
        for (int m = 0; m < 4; ++m) { const size_t off = (size_t)(u.pm * BM + wr * 64 + m * 16 + fr) * ldc + col0;
#pragma unroll
            for (int bj = 0; bj < 2; ++bj)
#pragma unroll
                for (int n = 0; n < 2; ++n) pre[m][bj][n] = *(const f32x4*)(base + off + bj * HALF + n * 16); }
        const bool bad = st.run(acc, u, wr, wc, fr, fq, lds, wid, lane) || poison != 0u;
        const float qnan = __builtin_nanf("");
#pragma unroll
        for (int ai = 0; ai < 2; ++ai)
#pragma unroll
            for (int m = 0; m < 4; ++m) { const int r = ai * HALF + wr * 64 + m * 16 + fr; const f32x2v sr = S[r]; const size_t off = (size_t)(u.pm * BM + r) * ldc + col0;
#pragma unroll
                for (int bj = 0; bj < 2; ++bj)
#pragma unroll
                    for (int n = 0; n < 2; ++n) { const f32x4 bs = ai == 0 ? pre[m][bj][n] : *(const f32x4*)(base + off + bj * HALF + n * 16); f32x4 o = bs + (acc[ai][bj][m][n] - sr.x) * sr.y;
                        if (bad) o = (f32x4){qnan, qnan, qnan, qnan}; *(f32x4*)(out + off + bj * HALF + n * 16) = o; }
                if (m & 1) asm volatile("" ::: "memory"); }
    }
};
struct EpiLnResLn {
    static constexpr bool PERM = false, AFTER_DRAIN = true;
    const float* base; float* out; bf16_t* xn; int ldc; const float* bias; PanelStats st1, st2; unsigned poison;
    __device__ __forceinline__ void fused(f32x4 (&acc)[2][2][4][2], const Unit& u, int wr, int wc, int fr, int fq, PG8_LAS unsigned char* lds, int wid, int lane) const {
        typedef float f32x2v __attribute__((ext_vector_type(2))); typedef unsigned u32x2v __attribute__((ext_vector_type(2)));
        const PG8_LAS f32x2v* S = (const PG8_LAS f32x2v*)(lds + 8192);
        const int col0 = u.pn * BM + wc * 32 + 4 * fq;
#pragma unroll
        for (int bj = 0; bj < 2; ++bj)
#pragma unroll
            for (int n = 0; n < 2; ++n) { const f32x4 bv = bias ? *(const f32x4*)(bias + col0 + bj * HALF + n * 16) : (f32x4){0.f, 0.f, 0.f, 0.f};
#pragma unroll
                for (int ai = 0; ai < 2; ++ai)
#pragma unroll
                    for (int m = 0; m < 4; ++m) acc[ai][bj][m][n] += bv; }
        bool bad = st1.run(acc, u, wr, wc, fr, fq, lds, wid, lane) || poison != 0u;
        const float qnan = __builtin_nanf("");
#pragma unroll
        for (int ai = 0; ai < 2; ++ai)
#pragma unroll
            for (int m = 0; m < 4; ++m) { const int r = ai * HALF + wr * 64 + m * 16 + fr; const f32x2v sr = S[r]; const size_t off = (size_t)(u.pm * BM + r) * ldc + col0;
#pragma unroll
                for (int bj = 0; bj < 2; ++bj)
#pragma unroll
                    for (int n = 0; n < 2; ++n) { const f32x4 bs = *(const f32x4*)(base + off + bj * HALF + n * 16); acc[ai][bj][m][n] = bs + (acc[ai][bj][m][n] - sr.x) * sr.y; }
                asm volatile("" : "+v"(acc[ai][0][m][0]), "+v"(acc[ai][0][m][1]), "+v"(acc[ai][1][m][0]), "+v"(acc[ai][1][m][1]));
                if (m & 1) asm volatile("" ::: "memory"); }
        const bool bad1 = bad;
        bad = st2.run(acc, u, wr, wc, fr, fq, lds, wid, lane) || bad;
#pragma unroll
        for (int ai = 0; ai < 2; ++ai)
#pragma unroll
            for (int m = 0; m < 4; ++m) { const int r = ai * HALF + wr * 64 + m * 16 + fr; const f32x2v sr = S[r]; const size_t off = (size_t)(u.pm * BM + r) * ldc + col0;
#pragma unroll
                for (int bj = 0; bj < 2; ++bj)
#pragma unroll
                    for (int n = 0; n < 2; ++n) { const f32x4 x1 = acc[ai][bj][m][n]; *(f32x4*)(out + off + bj * HALF + n * 16) = bad1 ? (f32x4){qnan, qnan, qnan, qnan} : x1;
                        const f32x4 o = (x1 - sr.x) * sr.y; u32x2v w; w.x = cvt_pk_bf16(o[0], o[1]); w.y = cvt_pk_bf16(o[2], o[3]);
                        if (bad) { w.x = 0x7fc07fc0u; w.y = 0x7fc07fc0u; } *(u32x2v*)(xn + off + bj * HALF + n * 16) = w; }
                asm volatile("" ::: "memory"); }
    }
};

template <class Epi, class Sched, bool ALIGN_EPI = false, bool SP2 = false>
__device__ __forceinline__ void gemm_phase(PG8_LAS unsigned char* lds, const Gemm g, const Sched& S, const Epi& E) {
    int tid_ = threadIdx.x; asm volatile("" : "+v"(tid_));
    const int tid = tid_, wid = __builtin_amdgcn_readfirstlane(tid >> 6), lane = tid & 63, wr = wid >> 2, wc = wid & 3, fr = lane & 15, fq = lane >> 4;
    const int K = g.K, nt = K / BK;
    unsigned voffA[2], voffB[2];
#pragma unroll
    for (int i = 0; i < 2; ++i) { int R, C; stage_rc(tid * 16 + i * 8192, R, C); const int Rb = Epi::PERM ? ((R & ~31) + perm32(R & 31)) : R;
        voffA[i] = (unsigned)(R * K + C) * 2u; voffB[i] = (unsigned)(Rb * K + C) * 2u; }
    const size_t kstep = (size_t)(BK * 2);
    const size_t hstep = (size_t)HALF * K * 2;
    const size_t tstep = 2 * hstep;
    const unsigned ldsw = (unsigned)wid * 1024u;
    const int aoff = lds_byte(wr * 64 + fr, fq * 8), boff = lds_byte(wc * 32 + fr, fq * 8);
#define PG8_SA(b, h) (((b) * 2 + (h)) * HTB)
#define PG8_SB(b, h) ((4 + (b) * 2 + (h)) * HTB)
#define PG8_STAGE(bufoff, gbase, voff) do { _Pragma("unroll") for (int _i = 0; _i < 2; ++_i) \
        __builtin_amdgcn_global_load_lds((const unsigned*)((const char*)(gbase) + (voff)[_i]), (PG8_LAS unsigned*)(lds + (bufoff) + ldsw + _i * 8192), 16, 0, 0); } while (0)
#define PG8_LDA(dst, b, h) do { _Pragma("unroll") for (int m = 0; m < 4; ++m) _Pragma("unroll") for (int k = 0; k < 2; ++k) dst[m][k] = *(const PG8_LAS bf16x8*)(lds + PG8_SA(b, h) + aoff + m * 2048 + k * 1024); } while (0)
#define PG8_LDB(dst, b, h) do { _Pragma("unroll") for (int n = 0; n < 2; ++n) _Pragma("unroll") for (int k = 0; k < 2; ++k) dst[n][k] = *(const PG8_LAS bf16x8*)(lds + PG8_SB(b, h) + boff + n * 2048 + k * 1024); } while (0)
#define PG8_MMA(ai, bj, At, Bt) do { __builtin_amdgcn_s_setprio(1); _Pragma("unroll") for (int m = 0; m < 4; ++m) _Pragma("unroll") for (int n = 0; n < 2; ++n) _Pragma("unroll") for (int k = 0; k < 2; ++k) \
        acc[ai][bj][m][n] = __builtin_amdgcn_mfma_f32_16x16x32_bf16(Bt[n][k], At[m][k], acc[ai][bj][m][n], 0, 0, 0); __builtin_amdgcn_s_setprio(0); } while (0)
#define PG8_WAIT_V(n) asm volatile("s_waitcnt vmcnt(" #n ")" ::: "memory")
#define PG8_WAIT_L(n) asm volatile("s_waitcnt lgkmcnt(" #n ")" ::: "memory")
#define PG8_BAR __builtin_amdgcn_s_barrier()
#define PG8_SCHED __builtin_amdgcn_sched_barrier(0)
    Unit cur, nxt; int ui = 0;
    if (!S.next(0, cur)) return;
    f32x4 acc[2][2][4][2];
#pragma unroll
    for (int a = 0; a < 2; ++a)
#pragma unroll
        for (int b = 0; b < 2; ++b)
#pragma unroll
            for (int m = 0; m < 4; ++m)
#pragma unroll
                for (int n = 0; n < 2; ++n) acc[a][b][m][n] = (f32x4){0.f, 0.f, 0.f, 0.f};
    bf16x8 At[4][2], B0[2][2], B1[2][2];
    const char* cA = (const char*)g.A + (size_t)cur.pm * tstep; const char* cB = (const char*)g.Bt + (size_t)cur.pn * tstep;
    S.a_ready(cur);
    if constexpr (SP2) {
        PG8_STAGE(PG8_SB(0, 0), cB, voffB); PG8_STAGE(PG8_SB(0, 1), cB + hstep, voffB); PG8_STAGE(PG8_SA(0, 0), cA, voffA); PG8_STAGE(PG8_SA(0, 1), cA + hstep, voffA);
        if (wr == 1) PG8_BAR;
        PG8_WAIT_V(2); PG8_BAR;
        PG8_STAGE(PG8_SB(1, 0), cB + kstep, voffB); PG8_STAGE(PG8_SA(1, 0), cA + kstep, voffA); PG8_STAGE(PG8_SB(1, 1), cB + hstep + kstep, voffB);
        PG8_WAIT_V(6); PG8_BAR;
    } else {
        PG8_STAGE(PG8_SB(0, 0), cB, voffB); PG8_STAGE(PG8_SA(0, 0), cA, voffA); PG8_STAGE(PG8_SB(0, 1), cB + hstep, voffB); PG8_STAGE(PG8_SA(0, 1), cA + hstep, voffA);
        if (wr == 1) PG8_BAR;
        PG8_WAIT_V(4); PG8_BAR;
        PG8_STAGE(PG8_SB(1, 0), cB + kstep, voffB); PG8_STAGE(PG8_SA(1, 0), cA + kstep, voffA); PG8_STAGE(PG8_SB(1, 1), cB + hstep + kstep, voffB);
        PG8_WAIT_V(6); PG8_BAR;
    }
    for (;;) {
        const bool has_next = S.next(ui + 1, nxt);
        const char* nA = has_next ? (const char*)g.A + (size_t)nxt.pm * tstep : cA; const char* nB = has_next ? (const char*)g.Bt + (size_t)nxt.pn * tstep : cB;
        for (int t = 0; t < nt; t += 2) {
            const bool last = (t == nt - 2);
            const char* a1 = cA + (size_t)(t + 1) * kstep;
            const char* a2 = last ? nA : cA + (size_t)(t + 2) * kstep; const char* b2 = last ? nB : cB + (size_t)(t + 2) * kstep;
            const char* a3 = a2 + kstep; const char* b3 = b2 + kstep;
            if (last && has_next) S.a_ready(nxt);
            if constexpr (SP2) {
            PG8_LDB(B0, 0, 0); PG8_LDB(B1, 0, 1); PG8_SCHED; PG8_LDA(At, 0, 0); PG8_STAGE(PG8_SA(1, 1), a1 + hstep, voffA);
            PG8_WAIT_V(8); PG8_WAIT_L(0); PG8_BAR; PG8_MMA(0, 0, At, B0); PG8_MMA(0, 1, At, B1); PG8_BAR; PG8_SCHED;
            PG8_LDA(At, 0, 1); PG8_STAGE(PG8_SB(0, 0), b2, voffB); PG8_STAGE(PG8_SB(0, 1), b2 + hstep, voffB); PG8_STAGE(PG8_SA(0, 0), a2, voffA);
            PG8_WAIT_V(8); PG8_WAIT_L(0); PG8_BAR; PG8_MMA(1, 0, At, B0); PG8_MMA(1, 1, At, B1); PG8_BAR; PG8_SCHED;
            PG8_LDB(B0, 1, 0); PG8_LDB(B1, 1, 1); PG8_SCHED; PG8_LDA(At, 1, 0); PG8_STAGE(PG8_SA(0, 1), a2 + hstep, voffA);
            PG8_WAIT_V(8); PG8_WAIT_L(0); PG8_BAR; PG8_MMA(0, 0, At, B0); PG8_MMA(0, 1, At, B1); PG8_BAR; PG8_SCHED;
            PG8_LDA(At, 1, 1); PG8_STAGE(PG8_SB(1, 0), b3, voffB); PG8_STAGE(PG8_SB(1, 1), b3 + hstep, voffB); PG8_STAGE(PG8_SA(1, 0), a3, voffA);
            PG8_WAIT_V(8); PG8_WAIT_L(0); PG8_BAR; PG8_MMA(1, 0, At, B0); PG8_MMA(1, 1, At, B1); PG8_BAR; PG8_SCHED;
            } else {
            PG8_LDB(B0, 0, 0); PG8_SCHED; PG8_LDA(At, 0, 0); PG8_STAGE(PG8_SA(1, 1), a1 + hstep, voffA);
            PG8_WAIT_L(8); PG8_BAR; PG8_WAIT_L(0); PG8_MMA(0, 0, At, B0); PG8_BAR; PG8_SCHED;
            PG8_LDB(B1, 0, 1); PG8_STAGE(PG8_SB(0, 0), b2, voffB);
            PG8_BAR; PG8_WAIT_L(0); PG8_MMA(0, 1, At, B1); PG8_BAR;
            PG8_LDA(At, 0, 1); PG8_STAGE(PG8_SA(0, 0), a2, voffA);
            PG8_BAR; PG8_WAIT_L(0); PG8_MMA(1, 0, At, B0); PG8_BAR; PG8_SCHED;
            PG8_STAGE(PG8_SB(0, 1), b2 + hstep, voffB);
            PG8_WAIT_V(6); PG8_BAR; PG8_MMA(1, 1, At, B1); PG8_BAR;
            PG8_LDB(B0, 1, 0); PG8_SCHED; PG8_LDA(At, 1, 0); PG8_STAGE(PG8_SA(0, 1), a2 + hstep, voffA);
            PG8_WAIT_L(8); PG8_BAR; PG8_WAIT_L(0); PG8_MMA(0, 0, At, B0); PG8_BAR; PG8_SCHED;
            PG8_LDB(B1, 1, 1); PG8_STAGE(PG8_SB(1, 0), b3, voffB);
            PG8_BAR; PG8_WAIT_L(0); PG8_MMA(0, 1, At, B1); PG8_BAR;
            PG8_LDA(At, 1, 1); PG8_STAGE(PG8_SA(1, 0), a3, voffA);
            PG8_BAR; PG8_WAIT_L(0); PG8_MMA(1, 0, At, B0); PG8_BAR; PG8_SCHED;
            PG8_STAGE(PG8_SB(1, 1), b3 + hstep, voffB);
            PG8_WAIT_V(6); PG8_BAR; PG8_MMA(1, 1, At, B1); PG8_BAR;
            }
        }
        if constexpr (ALIGN_EPI) { if (wr == 0) PG8_BAR; }
        if constexpr (!Epi::AFTER_DRAIN) { E(acc, cur, wr, wc, fr, fq); S.done(cur); }
        if (!has_next) break;
#pragma unroll
        for (int a = 0; a < 2; ++a)
#pragma unroll
            for (int b = 0; b < 2; ++b)
#pragma unroll
                for (int m = 0; m < 4; ++m)
#pragma unroll
                    for (int n = 0; n < 2; ++n) acc[a][b][m][n] = (f32x4){0.f, 0.f, 0.f, 0.f};
        cur = nxt; cA = nA; cB = nB; ++ui;
        if constexpr (ALIGN_EPI) { if (wr == 1) PG8_BAR; }
    }
    PG8_WAIT_V(0);
    if constexpr (!ALIGN_EPI) { if (wr == 0) PG8_BAR; }
    PG8_BAR;
    if constexpr (Epi::AFTER_DRAIN) { E.fused(acc, cur, wr, wc, fr, fq, lds, wid, lane); S.done(cur); }
#undef PG8_SA
#undef PG8_SB
#undef PG8_STAGE
#undef PG8_LDA
#undef PG8_LDB
#undef PG8_MMA
#undef PG8_WAIT_V
#undef PG8_WAIT_L
#undef PG8_BAR
#undef PG8_SCHED
}
}

namespace pg8 {
__device__ __forceinline__ float bf2f(unsigned short b) { return __uint_as_float(((unsigned)b) << 16); }
__device__ __forceinline__ float sigmoidf_(float x) { return 1.0f / (1.0f + __expf(-x)); }
struct EpiF32 {
    static constexpr bool PERM = false, AFTER_DRAIN = false;
    float* C; int ldc;
    __device__ __forceinline__ void operator()(const f32x4 (&acc)[2][2][4][2], const Unit& u, int wr, int wc, int fr, int fq) const {
        const int row0 = u.pm * BM + wr * 64 + fr, col0 = u.pn * BM + wc * 32 + 4 * fq;
#pragma unroll
        for (int ai = 0; ai < 2; ++ai)
#pragma unroll
            for (int m = 0; m < 4; ++m) { float* rowp = C + (size_t)(row0 + ai * HALF + m * 16) * ldc + col0;
#pragma unroll
                for (int bj = 0; bj < 2; ++bj)
#pragma unroll
                    for (int n = 0; n < 2; ++n) *(f32x4*)(rowp + bj * HALF + n * 16) = acc[ai][bj][m][n]; }
    }
};
struct EpiBranch {
    static constexpr bool PERM = false, AFTER_DRAIN = false;
    const bf16_t* gate; int ldg; float* tmp; bf16_t* out; int mode;
    __device__ __forceinline__ void operator()(const f32x4 (&acc)[2][2][4][2], const Unit& u, int wr, int wc, int fr, int fq) const {
        const int row0 = u.pm * BM + wr * 64 + fr, col0 = u.pn * BM + wc * 32 + 4 * fq;
#pragma unroll
        for (int ai = 0; ai < 2; ++ai)
#pragma unroll
            for (int m = 0; m < 4; ++m) { const size_t r = (size_t)(row0 + ai * HALF + m * 16);
#pragma unroll
                for (int bj = 0; bj < 2; ++bj)
#pragma unroll
                    for (int n = 0; n < 2; ++n) { const int c = col0 + bj * HALF + n * 16;
                        const uint2 gw = *(const uint2*)(gate + r * ldg + c);
                        f32x4 g; g[0] = sigmoidf_(__uint_as_float(gw.x << 16)); g[1] = sigmoidf_(__uint_as_float(gw.x & 0xffff0000u)); g[2] = sigmoidf_(__uint_as_float(gw.y << 16)); g[3] = sigmoidf_(__uint_as_float(gw.y & 0xffff0000u));
                        f32x4 v = g * acc[ai][bj][m][n];
                        float* tp = tmp + r * 1024 + c;
                        if (mode == 0) { *(f32x4*)tp = v; }
                        else if (mode == 1) { *(f32x4*)tp = *(const f32x4*)tp + v; }
                        else { v = *(const f32x4*)tp + v; uint2 w; w.x = cvt_pk_bf16(v[0], v[1]); w.y = cvt_pk_bf16(v[2], v[3]); *(uint2*)(out + r * 1024 + c) = w; } } }
    }
};
struct EpiSwiglu {
    static constexpr bool PERM = true, AFTER_DRAIN = false;
    bf16_t* O; int ldc;
    __device__ __forceinline__ void operator()(const f32x4 (&acc)[2][2][4][2], const Unit& u, int wr, int wc, int fr, int fq) const {
        const int row0 = u.pm * BM + wr * 64 + fr, col0 = u.pn * HALF + wc * 32 + 8 * fq;
#pragma unroll
        for (int ai = 0; ai < 2; ++ai)
#pragma unroll
            for (int m = 0; m < 4; ++m) { bf16_t* rowp = O + (size_t)(row0 + ai * HALF + m * 16) * ldc + col0;
                float h[8];
#pragma unroll
                for (int n = 0; n < 2; ++n)
#pragma unroll
                    for (int i = 0; i < 4; ++i) { const float g = acc[ai][0][m][n][i], up = acc[ai][1][m][n][i]; h[n * 4 + i] = g * sigmoidf_(g) * up; }
                u32x4 w; w.x = cvt_pk_bf16(h[0], h[1]); w.y = cvt_pk_bf16(h[2], h[3]); w.z = cvt_pk_bf16(h[4], h[5]); w.w = cvt_pk_bf16(h[6], h[7]);
                *(u32x4*)rowp = w; }
    }
};
}

constexpr int BATCH = 2, SEQ = 8192, D = 1024, M = BATCH * SEQ, DEPTH = 4;
constexpr int NP = 8192;
constexpr int FFH = 2816;
constexpr int C_ATQ = 0, C_ATK = 512, C_ATV = 1024, C_GQ = 1536, C_GK = 1792, C_GV = 2048, C_GG = 2560;
constexpr int C_RR = 3072, C_RK = 3584, C_RV = 4096, C_RLO = 4608  , C_GA = 4864, C_GATE = 5120;
constexpr float LN_EPS = 1e-5f, GLA_EPS = 1e-5f, GN_EPS = 64e-5f;
constexpr float DN_ALPHA = 1.6817928305074290861f;

constexpr size_t MiB = 1u << 20;
constexpr size_t WS_CTL = 0, CTL_ZERO_BYTES = 1 * MiB;
constexpr size_t WS_MOD = 1 * MiB;
constexpr size_t WS_WIN = 2 * MiB;
constexpr size_t WS_WBR = WS_WIN + 16 * MiB;
constexpr size_t WS_WOUT = WS_WBR + 3 * MiB;
constexpr size_t WS_W1 = WS_WOUT + 2 * MiB;
constexpr size_t WS_W2 = WS_W1 + 11 * MiB;
constexpr size_t WS_UB = 40 * MiB;
constexpr size_t WS_BR = WS_UB + 32 * MiB;
constexpr size_t WS_RW = WS_BR + 48 * MiB;
constexpr size_t WS_GO = WS_RW + 48 * MiB;
constexpr size_t WS_TMP = WS_RW;
constexpr size_t WS_P = WS_GO + 32 * MiB;
constexpr size_t WS_H = WS_P;
constexpr size_t WS_HID = WS_P + 64 * MiB;
constexpr size_t WS_END = WS_P + 256 * MiB;
static_assert(WS_W2 + (size_t)1024 * 2816 * 2 <= WS_UB, "weights fit");
constexpr int CW_BAR = 4096;

#define LAS __attribute__((address_space(3)))
typedef unsigned short bf16;
typedef float f32x4 __attribute__((ext_vector_type(4)));
typedef unsigned v4u __attribute__((ext_vector_type(4)));
__device__ __forceinline__ float bf2f(bf16 b) { return __uint_as_float(((unsigned)b) << 16); }
__device__ __forceinline__ unsigned f2bf(float f) { unsigned u = __float_as_uint(f); return (u + 0x7fffu + ((u >> 16) & 1u)) >> 16; }
__device__ __forceinline__ unsigned pk2(float lo, float hi) { return f2bf(lo) | (f2bf(hi) << 16); }
__device__ __forceinline__ float sigm(float x) { return 1.0f / (1.0f + __expf(-x)); }
__device__ __forceinline__ float softplusf_(float x) { return fmaxf(x, 0.f) + log1pf(__expf(-fabsf(x))); }
__device__ __forceinline__ float wave_sum(float v) {
#pragma unroll
    for (int o = 1; o < 64; o <<= 1) v += __shfl_xor(v, o);
    return v;
}
__device__ __forceinline__ float wave_max(float v) {
#pragma unroll
    for (int o = 1; o < 64; o <<= 1) v = fmaxf(v, __shfl_xor(v, o));
    return v;
}
#define LDS_WAIT() asm volatile("s_waitcnt lgkmcnt(0)" ::: "memory")
template <class T> __device__ __forceinline__ T* launder(T* p) { asm volatile("" : "+s"(p)); return p; }

#define XB_TMO      128
#define XB_XCNT(j)  (256  + 64 * (j))
#define XB_XSUB(j)  (1280 + 64 * (j))
#define XB_XGEN(j)  (2304 + 64 * (j))
#define XB_TOP      3328
#define XB_TOPGEN   3392
#define XCD_BAR_WORDS 3456
#define XB_SPIN_CAP (1u << 18)
__device__ __forceinline__ unsigned xb_ld(unsigned* p)              { return __hip_atomic_load(p, __ATOMIC_RELAXED, __HIP_MEMORY_SCOPE_AGENT); }
__device__ __forceinline__ unsigned xb_add(unsigned* p, unsigned v) { return __hip_atomic_fetch_add(p, v, __ATOMIC_RELAXED, __HIP_MEMORY_SCOPE_AGENT); }
__device__ __forceinline__ unsigned xb_xcc_id() { return (unsigned)__builtin_amdgcn_s_getreg((3 << 11) | 20) & 0xFu; }
#define XB_SPIN(cond, bar) do { unsigned _sp = 0; while (cond) { __builtin_amdgcn_s_sleep(1); \
    if ((++_sp & 255u) == 0u) { if (xb_ld(&(bar)[XB_TMO])) break; if (_sp > XB_SPIN_CAP) { atomicAdd(&(bar)[XB_TMO], 1u); break; } } } } while (0)
struct XcdBarrier { unsigned* bar; unsigned x; volatile LAS unsigned* st; };
__device__ __forceinline__ XcdBarrier xcd_barrier_post(unsigned* bar, volatile LAS unsigned* st) {
    XcdBarrier b; b.bar = bar; b.x = xb_xcc_id(); b.st = st;
    if (threadIdx.x == 0) (void)xb_add(&bar[XB_XCNT(b.x)], 1u);
    return b;
}
__device__ __forceinline__ void xcd_barrier_complete(unsigned* bar, unsigned x, unsigned& nloc, unsigned& nx) {
    const unsigned G = gridDim.x * gridDim.y * gridDim.z;
    unsigned sum, cnt, mine, sp = 0u;
    for (;;) {
        sum = 0u; cnt = 0u; mine = 0u;
#pragma unroll
        for (unsigned j = 0; j < 16; ++j) { const unsigned c = xb_ld(&bar[XB_XCNT(j)]); sum += c; cnt += (c > 0u) ? 1u : 0u; mine = (j == x) ? c : mine; }
        if (sum == G) break;
        __builtin_amdgcn_s_sleep(1);
        if ((++sp & 255u) == 0u) { if (xb_ld(&bar[XB_TMO])) break; if (sp > XB_SPIN_CAP) { atomicAdd(&bar[XB_TMO], 1u); break; } }
    }
    nloc = mine > 0u ? mine : 1u; nx = cnt > 0u ? cnt : 1u;
}
__device__ __forceinline__ void xcd_barrier(const XcdBarrier& b) {
    asm volatile("s_waitcnt vmcnt(0)" ::: "memory");
    __syncthreads();
    if (threadIdx.x == 0) {
        unsigned* bar = b.bar;
        __builtin_amdgcn_s_waitcnt(0);
        unsigned nloc = b.st[0], nx = b.st[1];
        if (nloc == 0u) { xcd_barrier_complete(bar, b.x, nloc, nx); b.st[0] = nloc; b.st[1] = nx; }
        const unsigned old = xb_add(&bar[XB_XSUB(b.x)], 1u);
        const unsigned gen = old / nloc;
        if (old + 1u == (gen + 1u) * nloc) {
            __builtin_amdgcn_fence(__ATOMIC_RELEASE, "agent");
            asm volatile("s_waitcnt vmcnt(0)" ::: "memory");
            const unsigned og = xb_add(&bar[XB_TOP], 1u);
            const unsigned tg = og / nx;
            if (og + 1u == (tg + 1u) * nx) xb_add(&bar[XB_TOPGEN], 1u);
            else XB_SPIN(xb_ld(&bar[XB_TOPGEN]) == tg, bar);
            __builtin_amdgcn_fence(__ATOMIC_ACQUIRE, "agent");
            xb_add(&bar[XB_XGEN(b.x)], 1u);
            asm volatile("s_waitcnt vmcnt(0)" ::: "memory");
        } else {
            XB_SPIN(xb_ld(&bar[XB_XGEN(b.x)]) == gen, bar);
            __builtin_amdgcn_fence(__ATOMIC_ACQUIRE, "agent");
            asm volatile("s_waitcnt vmcnt(0)" ::: "memory");
        }
    }
    __syncthreads();
}

constexpr int N_IN = 27;
enum { I_X = 0, I_C, I_WADA, I_BADA, I_WIN, I_GWA, I_GBA, I_GNG, I_RMU, I_RW0, I_RWUP, I_RA0, I_RAUP, I_RGUP, I_RKK, I_RKA, I_RRK, I_RGNG, I_RGNB, I_WBR, I_WOUT, I_LN1G, I_LN1B, I_W1, I_W2, I_LN2G, I_LN2B };
struct Args { const float* in[N_IN]; float* out; unsigned char* ws; int ph_lo, ph_hi; };
static_assert(sizeof(Args) == N_IN * 8 + 8 + 8 + 8, "Args has no padding");

constexpr int NWAVES = 8, NTHR = 512;
constexpr int RING_BYTES = 131072, MISC_OFF = RING_BYTES + 320, LDS_BYTES = 147456;

struct Frame {
    LAS unsigned char* lds; int tid, lane, wave, bid, G;
    const float* const* in; float* out; unsigned char* ws;
};

__device__ __forceinline__ void phase_mod(const Frame& F) {
    LAS float* sc = (LAS float*)F.lds;
    LAS float* part = sc + 2048;
    const float* c = F.in[I_C];
    for (int i = F.tid; i < 2048; i += NTHR) { const float v = c[i]; sc[i] = v * sigm(v); }
    __syncthreads();
    float* mod = (float*)(F.ws + WS_MOD);
    for (int item = F.bid; item < DEPTH * 96; item += F.G) {
        const int l = item / 96, cg = item % 96, col = cg * 64 + F.lane;
        const float* W = F.in[I_WADA] + (size_t)l * 1024 * 6144 + col;
        float s0 = 0.f, s1 = 0.f; const int k0 = F.wave * 128;
#pragma unroll 8
        for (int kk = 0; kk < 128; ++kk) { const int k = k0 + kk; const float w = W[(size_t)k * 6144]; s0 += sc[k] * w; s1 += sc[1024 + k] * w; }
        part[(F.wave * 2 + 0) * 64 + F.lane] = s0; part[(F.wave * 2 + 1) * 64 + F.lane] = s1;
        __syncthreads();
        if (F.wave < 2) { float t = 0.f;
#pragma unroll
            for (int w = 0; w < 8; ++w) t += part[(w * 2 + F.wave) * 64 + F.lane];
            mod[(size_t)(l * 2 + F.wave) * 6144 + col] = t + F.in[I_BADA][l * 6144 + col]; }
        __syncthreads();
    }
}
__device__ __forceinline__ int map_col(int mode, int n) {
    if (mode == 1) {
        if (n < 1536) return 3344 + n;
        if (n < 2560) return n - 1536;
        if (n < 3072) return 1040 + (n - 2560);
        if (n < 4864) return 1552 + (n - 3072);
        if (n < 4880) return 1024 + (n - 4864);
        if (n < 5120) return -1;
        return 4880 + (n - 5120);
    }
    if (mode == 2) { const int j = n >> 8, w = n & 255; return (w < 128) ? (j * 128 + w) : (FFH + j * 128 + (w - 128)); }
    return n;
}
__device__ __forceinline__ void transpose_item(const float* W, int K, int Nsrc, bf16* WT, int mode, int nblk, LAS float* scr, int item, int lane) {
    const int kb = item / nblk, nb = item % nblk, k0 = 64 * kb, n0 = 32 * nb;
    const int oc = map_col(mode, n0 + (lane & 31));
#pragma unroll 8
    for (int i = 0; i < 32; ++i) { const int kk = 2 * i + (lane >> 5); scr[kk * 33 + (lane & 31)] = (oc >= 0) ? W[(size_t)(k0 + kk) * Nsrc + oc] : 0.f; }
    LDS_WAIT(); asm volatile("" ::: "memory");
    const int c = lane & 7;
#pragma unroll
    for (int j = 0; j < 4; ++j) { const int n = (lane >> 3) + 8 * j; const LAS float* s = scr + (8 * c) * 33 + n;
        v4u o; o.x = pk2(s[0 * 33], s[1 * 33]); o.y = pk2(s[2 * 33], s[3 * 33]); o.z = pk2(s[4 * 33], s[5 * 33]); o.w = pk2(s[6 * 33], s[7 * 33]);
        *(v4u*)(WT + (size_t)(n0 + n) * K + k0 + 8 * c) = o; }
    LDS_WAIT(); asm volatile("" ::: "memory");
}
__device__ __forceinline__ void convert_weights(const Frame& F, int l) {
    LAS float* scr = (LAS float*)(F.lds + F.wave * 16384);
    const int gw = F.bid * NWAVES + F.wave, NGW = F.G * NWAVES;
    constexpr int I_IN = 16 * 256, I_BR = 8 * 32, I_OUT = 16 * 32, I_1 = 16 * 176, I_2 = 44 * 32;
    constexpr int NITEMS = I_IN + 3 * I_BR + I_OUT + I_1 + I_2;
    for (int it = gw; it < NITEMS; it += NGW) {
        int r = it;
        if (r < I_IN) { transpose_item(F.in[I_WIN] + (size_t)l * 1024 * 7952, 1024, 7952, (bf16*)(F.ws + WS_WIN), 1, 256, scr, r, F.lane); continue; } r -= I_IN;
        if (r < 3 * I_BR) { const int n = r / I_BR; transpose_item(F.in[I_WBR] + (size_t)(l * 3 + n) * 512 * 1024, 512, 1024, (bf16*)(F.ws + WS_WBR) + (size_t)n * 1024 * 512, 0, 32, scr, r % I_BR, F.lane); continue; } r -= 3 * I_BR;
        if (r < I_OUT) { transpose_item(F.in[I_WOUT] + (size_t)l * 1024 * 1024, 1024, 1024, (bf16*)(F.ws + WS_WOUT), 0, 32, scr, r, F.lane); continue; } r -= I_OUT;
        if (r < I_1) { transpose_item(F.in[I_W1] + (size_t)l * 1024 * 5632, 1024, 5632, (bf16*)(F.ws + WS_W1), 2, 176, scr, r, F.lane); continue; } r -= I_1;
        transpose_item(F.in[I_W2] + (size_t)l * 2816 * 1024, 2816, 1024, (bf16*)(F.ws + WS_W2), 0, 32, scr, r, F.lane);
    }
}
__device__ __forceinline__ void make_u0(const Frame& F) {
    const int gw = F.bid * NWAVES + F.wave, NGW = F.G * NWAVES;
    const float* mod = (const float*)(F.ws + WS_MOD);
    bf16* ub = (bf16*)(F.ws + WS_UB);
    for (int m = gw; m < M; m += NGW) {
        const int b = m / SEQ; const float* sh = mod + (size_t)(0 * 2 + b) * 6144; const float* scp = sh + 1024;
        const f32x4* xr = (const f32x4*)(F.in[I_X] + (size_t)m * D) + F.lane;
        unsigned long long* o8 = (unsigned long long*)(ub + (size_t)m * D) + F.lane;
#pragma unroll
        for (int j = 0; j < 4; ++j) { const f32x4 v = xr[64 * j]; const f32x4 s = *((const f32x4*)scp + F.lane + 64 * j), h = *((const f32x4*)sh + F.lane + 64 * j);
            const f32x4 u = v * (1.0f + s) + h;
            o8[64 * j] = (unsigned long long)pk2(u[0], u[1]) | ((unsigned long long)pk2(u[2], u[3]) << 32); }
    }
}
__device__ __forceinline__ void phase_ln(const Frame& F, const float* xold, const float* h, const float* gmod  , const float* lg, const float* lb,
                                         float* xout, const float* shmod  , bf16* ub) {
    const int gw = F.bid * NWAVES + F.wave, NGW = F.G * NWAVES;
    for (int m = gw; m < M; m += NGW) {
        const int b = m / SEQ;
        const f32x4* xr = (const f32x4*)(xold + (size_t)m * D) + F.lane; const f32x4* hr = (const f32x4*)(h + (size_t)m * D) + F.lane;
        const f32x4* gr = (const f32x4*)(gmod + (size_t)b * 6144) + F.lane;
        f32x4 v[4]; float s = 0.f;
#pragma unroll
        for (int j = 0; j < 4; ++j) { v[j] = DN_ALPHA * xr[64 * j] + (1.0f + gr[64 * j]) * hr[64 * j]; s += (v[j][0] + v[j][1]) + (v[j][2] + v[j][3]); }
        const float mean = wave_sum(s) * (1.f / D); float s2 = 0.f;
#pragma unroll
        for (int j = 0; j < 4; ++j) { v[j] = v[j] - mean; s2 += (v[j][0] * v[j][0] + v[j][1] * v[j][1]) + (v[j][2] * v[j][2] + v[j][3] * v[j][3]); }
        const float rstd = 1.f / sqrtf(wave_sum(s2) * (1.f / D) + LN_EPS);
        f32x4* xo = (f32x4*)(xout + (size_t)m * D) + F.lane;
        unsigned long long* o8 = (unsigned long long*)(ub + (size_t)m * D) + F.lane;
#pragma unroll
        for (int j = 0; j < 4; ++j) { const f32x4 y = v[j] * rstd * *((const f32x4*)lg + F.lane + 64 * j) + *((const f32x4*)lb + F.lane + 64 * j);
            xo[64 * j] = y;
            if (shmod) { const f32x4 sh = *((const f32x4*)(shmod + (size_t)b * 6144) + F.lane + 64 * j), sc = *((const f32x4*)(shmod + (size_t)b * 6144 + 1024) + F.lane + 64 * j);
                const f32x4 u = y * (1.0f + sc) + sh; o8[64 * j] = (unsigned long long)pk2(u[0], u[1]) | ((unsigned long long)pk2(u[2], u[3]) << 32); } }
    }
}
__device__ __forceinline__ void phase_rwprep(const Frame& F, int l) {
    LAS float* inl = (LAS float*)F.lds;
    const bf16* P = (const bf16*)(F.ws + WS_P);
    bf16* rw_lw = (bf16*)(F.ws + WS_RW); bf16* rw_a = rw_lw + (size_t)M * 512; bf16* rw_g = rw_a + (size_t)M * 512;
    const float* mu = F.in[I_RMU] + l * 1792 + 1536;
    const float* w_up = F.in[I_RWUP] + (size_t)l * 64 * 512; const float* a_up = F.in[I_RAUP] + (size_t)l * 64 * 512; const float* g_up = F.in[I_RGUP] + (size_t)l * 128 * 512;
    const int c = F.tid;
    const float w0 = F.in[I_RW0][l * 512 + c], a0 = F.in[I_RA0][l * 512 + c];
    for (int item = F.bid; item < M / 16; item += F.G) {
        const int m0 = item * 16;
#pragma unroll
        for (int i = 0; i < 8; ++i) { const int idx = i * NTHR + F.tid, t = idx >> 8, j = idx & 255, m = m0 + t;
            const float cur = bf2f(P[(size_t)m * NP + C_RLO + j]); const float prev = (m % SEQ == 0) ? 0.f : bf2f(P[(size_t)(m - 1) * NP + C_RLO + j]);
            const float xs = cur + (prev - cur) * mu[j];
            inl[j * 16 + t] = (j < 64) ? tanhf(xs) : ((j < 128) ? xs : sigm(xs)); }
        __syncthreads();
        float aw[16], aa[16], ag[16];
#pragma unroll
        for (int t = 0; t < 16; ++t) { aw[t] = 0.f; aa[t] = 0.f; ag[t] = 0.f; }
#pragma unroll 4
        for (int j = 0; j < 64; ++j) { const float w = w_up[j * 512 + c]; const LAS f32x4* p = (const LAS f32x4*)(inl + j * 16);
#pragma unroll
            for (int q = 0; q < 4; ++q) { const f32x4 x = p[q]; aw[q * 4 + 0] += x[0] * w; aw[q * 4 + 1] += x[1] * w; aw[q * 4 + 2] += x[2] * w; aw[q * 4 + 3] += x[3] * w; } }
#pragma unroll 4
        for (int j = 0; j < 64; ++j) { const float w = a_up[j * 512 + c]; const LAS f32x4* p = (const LAS f32x4*)(inl + (64 + j) * 16);
#pragma unroll
            for (int q = 0; q < 4; ++q) { const f32x4 x = p[q]; aa[q * 4 + 0] += x[0] * w; aa[q * 4 + 1] += x[1] * w; aa[q * 4 + 2] += x[2] * w; aa[q * 4 + 3] += x[3] * w; } }
#pragma unroll 4
        for (int j = 0; j < 128; ++j) { const float w = g_up[j * 512 + c]; const LAS f32x4* p = (const LAS f32x4*)(inl + (128 + j) * 16);
#pragma unroll
            for (int q = 0; q < 4; ++q) { const f32x4 x = p[q]; ag[q * 4 + 0] += x[0] * w; ag[q * 4 + 1] += x[1] * w; ag[q * 4 + 2] += x[2] * w; ag[q * 4 + 3] += x[3] * w; } }
#pragma unroll
        for (int t = 0; t < 16; ++t) { const size_t o = (size_t)(m0 + t) * 512 + c;
            const float wl = -softplusf_(-(w0 + aw[t])) - 0.5f;
            rw_lw[o] = (bf16)f2bf(-__expf(wl)); rw_a[o] = (bf16)f2bf(sigm(a0 + aa[t])); rw_g[o] = (bf16)f2bf(ag[t]); }
        __syncthreads();
    }
}
__device__ __forceinline__ void rwkv_scan_wave(const Frame& F, int l, int bh) {
    const int b = bh >> 3, h = bh & 7, lane = F.lane, c = h * 64 + lane;
    LAS float* L = (LAS float*)F.lds;
    LAS float* Lkk = L, *Lw = L + 1024, *Lb = L + 2048, *Lk = L + 3072, *Lr = L + 4096, *Lv = L + 5120, *Ly = L + 6144, *Lrk = L + 7168;
    const bf16* P = (const bf16*)(F.ws + WS_P);
    const bf16* rw_lw = (const bf16*)(F.ws + WS_RW); const bf16* rw_a = rw_lw + (size_t)M * 512; const bf16* rw_g = rw_a + (size_t)M * 512;
    bf16* outB = (bf16*)(F.ws + WS_BR) + (size_t)M * 512;
    const float* mu = F.in[I_RMU] + l * 1792;
    const float mu_r = mu[c], mu_k = mu[512 + c], mu_v = mu[1024 + c];
    const float k_k = F.in[I_RKK][l * 512 + c], k_a = F.in[I_RKA][l * 512 + c], r_k = F.in[I_RRK][l * 512 + c], gn_g = F.in[I_RGNG][l * 512 + c], gn_b = F.in[I_RGNB][l * 512 + c];
    float S[64];
#pragma unroll
    for (int k = 0; k < 64; ++k) S[k] = 0.f;
    float pr = 0.f, pk = 0.f, pv = 0.f;
    for (int t0 = 0; t0 < SEQ; t0 += 16) {
        float cr[16], ck[16], cv[16], lw[16], av[16];
#pragma unroll
        for (int t = 0; t < 16; ++t) { const size_t m = (size_t)b * SEQ + t0 + t; const bf16* pp = P + m * NP;
            cr[t] = bf2f(pp[C_RR + c]); ck[t] = bf2f(pp[C_RK + c]); cv[t] = bf2f(pp[C_RV + c]); lw[t] = bf2f(rw_lw[m * 512 + c]); av[t] = bf2f(rw_a[m * 512 + c]); }
#pragma unroll
        for (int t = 0; t < 16; ++t) {
            const float r = cr[t] + (pr - cr[t]) * mu_r, k = ck[t] + (pk - ck[t]) * mu_k, v = cv[t] + (pv - cv[t]) * mu_v;
            pr = cr[t]; pk = ck[t]; pv = cv[t];
            const float a = av[t];
            const float kkv = k * k_k; const float n2 = wave_sum(kkv * kkv); const float kk = kkv / fmaxf(sqrtf(n2), 1e-12f);
            const float kp = k * (1.0f + (a - 1.0f) * k_a);
            const float rk = wave_sum(r * kp * r_k);
            Lkk[t * 64 + lane] = kk; Lw[t * 64 + lane] = __expf(lw[t]); Lb[t * 64 + lane] = kk * a; Lk[t * 64 + lane] = kp; Lr[t * 64 + lane] = r; Lv[t * 64 + lane] = v;
            if (lane == 0) Lrk[t] = rk;
        }
        LDS_WAIT(); asm volatile("" ::: "memory");
#pragma unroll 1
        for (int t = 0; t < 16; ++t) {
            const LAS f32x4* q_kk = (const LAS f32x4*)(Lkk + t * 64); const LAS f32x4* q_w = (const LAS f32x4*)(Lw + t * 64); const LAS f32x4* q_b = (const LAS f32x4*)(Lb + t * 64);
            const LAS f32x4* q_k = (const LAS f32x4*)(Lk + t * 64); const LAS f32x4* q_r = (const LAS f32x4*)(Lr + t * 64);
            const float vt = Lv[t * 64 + lane];
            float sa = 0.f;
#pragma unroll
            for (int k4 = 0; k4 < 16; ++k4) { const f32x4 x = q_kk[k4]; sa -= S[4 * k4] * x[0]; sa -= S[4 * k4 + 1] * x[1]; sa -= S[4 * k4 + 2] * x[2]; sa -= S[4 * k4 + 3] * x[3]; }
            float y = 0.f;
#pragma unroll
            for (int k4 = 0; k4 < 16; ++k4) { const f32x4 w = q_w[k4], bb = q_b[k4], kx = q_k[k4], rr = q_r[k4];
#pragma unroll
                for (int i = 0; i < 4; ++i) { const float s = S[4 * k4 + i] * w[i] + sa * bb[i] + vt * kx[i]; S[4 * k4 + i] = s; y += s * rr[i]; } }
            Ly[t * 64 + lane] = y;
        }
        LDS_WAIT(); asm volatile("" ::: "memory");
#pragma unroll 4
        for (int t = 0; t < 16; ++t) { const size_t m = (size_t)b * SEQ + t0 + t;
            const float y = Ly[t * 64 + lane]; const float mean = wave_sum(y) * (1.f / 64.f); const float d = y - mean; const float var = wave_sum(d * d) * (1.f / 64.f);
            const float yn = d * (1.0f / sqrtf(var + GN_EPS)) * gn_g + gn_b;
            const float o = (yn + Lrk[t] * Lv[t * 64 + lane]) * bf2f(rw_g[m * 512 + c]);
            outB[m * 512 + c] = (bf16)f2bf(o); }
        LDS_WAIT(); asm volatile("" ::: "memory");
    }
}
__device__ __forceinline__ void gla_scan_wave(const Frame& F, int l, int idx) {
    const int half = idx & 1, bh = idx >> 1, b = bh >> 2, h = bh & 3, lane = F.lane, ck = h * 64 + lane, vcol = h * 128 + half * 64 + lane;
    LAS float* L = (LAS float*)F.lds;
    LAS float* La = L, *Lk = L + 1024, *Lq = L + 2048, *Lv = L + 3072, *Lga = L + 4096;
    const bf16* P = (const bf16*)(F.ws + WS_P);
    float* GO = (float*)(F.ws + WS_GO);
    const float* wa = F.in[I_GWA] + (size_t)l * 16 * 256; const float ba = F.in[I_GBA][l * 256 + ck];
    float war[16];
#pragma unroll
    for (int j = 0; j < 16; ++j) war[j] = wa[j * 256 + ck];
    float S[64];
#pragma unroll
    for (int k = 0; k < 64; ++k) S[k] = 0.f;
    for (int t0 = 0; t0 < SEQ; t0 += 16) {
        const size_t m0 = (size_t)b * SEQ + t0;
        { const int t = lane >> 2, q = lane & 3; const uint2 gw = *(const uint2*)(P + (m0 + t) * NP + C_GA + 4 * q);
          LAS float* d = Lga + t * 16 + 4 * q; d[0] = __uint_as_float(gw.x << 16); d[1] = __uint_as_float(gw.x & 0xffff0000u); d[2] = __uint_as_float(gw.y << 16); d[3] = __uint_as_float(gw.y & 0xffff0000u); }
        float kx[16], qx[16], vx[16];
#pragma unroll
        for (int t = 0; t < 16; ++t) { const bf16* pp = P + (m0 + t) * NP; kx[t] = bf2f(pp[C_GK + ck]); qx[t] = bf2f(pp[C_GQ + ck]) * 0.125f; vx[t] = bf2f(pp[C_GV + vcol]); }
        LDS_WAIT(); asm volatile("" ::: "memory");
#pragma unroll
        for (int t = 0; t < 16; ++t) {
            float z = ba; const LAS f32x4* g4 = (const LAS f32x4*)(Lga + t * 16);
#pragma unroll
            for (int j4 = 0; j4 < 4; ++j4) { const f32x4 g = g4[j4]; z += g[0] * war[4 * j4] + g[1] * war[4 * j4 + 1] + g[2] * war[4 * j4 + 2] + g[3] * war[4 * j4 + 3]; }
            const float ls = fminf(z, 0.f) - log1pf(__expf(-fabsf(z)));
            La[t * 64 + lane] = __expf(ls * (1.0f / 16.0f)); Lk[t * 64 + lane] = kx[t]; Lq[t * 64 + lane] = qx[t]; Lv[t * 64 + lane] = vx[t]; }
        LDS_WAIT(); asm volatile("" ::: "memory");
#pragma unroll 1
        for (int t = 0; t < 16; ++t) {
            const LAS f32x4* q_a = (const LAS f32x4*)(La + t * 64); const LAS f32x4* q_k = (const LAS f32x4*)(Lk + t * 64); const LAS f32x4* q_q = (const LAS f32x4*)(Lq + t * 64);
            const float vt = Lv[t * 64 + lane]; float o = 0.f;
#pragma unroll
            for (int k4 = 0; k4 < 16; ++k4) { const f32x4 a = q_a[k4], kk = q_k[k4], qq = q_q[k4];
#pragma unroll
                for (int i = 0; i < 4; ++i) { const float s = a[i] * S[4 * k4 + i] + kk[i] * vt; S[4 * k4 + i] = s; o += qq[i] * s; } }
            GO[(m0 + t) * 512 + vcol] = o;
        }
        LDS_WAIT(); asm volatile("" ::: "memory");
    }
}
__device__ __forceinline__ void attn_waves(const Frame& F, int wave_id, int nwaves) {
    LAS float* L = (LAS float*)(F.lds + 65536) + F.wave * 512;
    LAS float* Lq = L, *Lp = L + 64;
    const bf16* P = (const bf16*)(F.ws + WS_P);
    bf16* outC = (bf16*)(F.ws + WS_BR) + (size_t)2 * M * 512;
    const int lane = F.lane;
    for (int qi = wave_id; qi < BATCH * 8 * SEQ; qi += nwaves) {
        const int t = qi % SEQ, bh = qi / SEQ, h = bh & 7, b = bh >> 3;
        const size_t m = (size_t)b * SEQ + t;
        const float slope = exp2f(-(float)(h + 1));
        Lq[lane] = bf2f(P[m * NP + C_ATQ + h * 64 + lane]);
        LDS_WAIT(); asm volatile("" ::: "memory");
        float sc[7]; float mx = -INFINITY;
#pragma unroll
        for (int r = 0; r < 7; ++r) { const int e = r * 64 + lane; const int pi = e / 129, j = e - pi * 129; const int d = (pi == 0) ? 1 : ((pi == 1) ? 4 : 16); const int pos = t - j * d;
            float s = -INFINITY;
            if (e < 387 && pos >= 0) { const v4u* kr = (const v4u*)(P + ((size_t)b * SEQ + pos) * NP + C_ATK + h * 64); float dot = 0.f;
#pragma unroll
                for (int i = 0; i < 8; ++i) { const v4u kw = kr[i]; const LAS f32x4* q4 = (const LAS f32x4*)(Lq + i * 8); const f32x4 qa = q4[0], qb = q4[1];
                    dot += qa[0] * __uint_as_float(kw.x << 16) + qa[1] * __uint_as_float(kw.x & 0xffff0000u) + qa[2] * __uint_as_float(kw.y << 16) + qa[3] * __uint_as_float(kw.y & 0xffff0000u)
                         + qb[0] * __uint_as_float(kw.z << 16) + qb[1] * __uint_as_float(kw.z & 0xffff0000u) + qb[2] * __uint_as_float(kw.w << 16) + qb[3] * __uint_as_float(kw.w & 0xffff0000u); }
                s = dot * 0.125f - slope * (float)(j * d); }
            sc[r] = s; mx = fmaxf(mx, s); }
        mx = wave_max(mx);
        float den = 0.f;
#pragma unroll
        for (int r = 0; r < 7; ++r) { const float p = (sc[r] == -INFINITY) ? 0.f : __expf(sc[r] - mx); den += p; Lp[r * 64 + lane] = p; }
        den = wave_sum(den);
        LDS_WAIT(); asm volatile("" ::: "memory");
        float acc = 0.f;
#pragma unroll
        for (int pi = 0; pi < 3; ++pi) { const int d = (pi == 0) ? 1 : ((pi == 1) ? 4 : 16); const int jmax = min(128, t / d);
            const bf16* vb = P + ((size_t)b * SEQ + t) * NP + C_ATV + h * 64 + lane;
#pragma unroll 4
            for (int j = 0; j <= jmax; ++j) { const float p = Lp[pi * 129 + j]; acc += p * bf2f(vb[-(ptrdiff_t)j * d * NP]); } }
        outC[m * 512 + h * 64 + lane] = (bf16)f2bf(acc / den);
        LDS_WAIT(); asm volatile("" ::: "memory");
    }
}
__device__ __forceinline__ void phase_gla_post(const Frame& F, int l) {
    const int gw = F.bid * NWAVES + F.wave, NGW = F.G * NWAVES;
    const float* GO = (const float*)(F.ws + WS_GO); const bf16* P = (const bf16*)(F.ws + WS_P);
    bf16* outA = (bf16*)(F.ws + WS_BR);
    const float ng0 = F.in[I_GNG][l * 128 + 2 * F.lane], ng1 = F.in[I_GNG][l * 128 + 2 * F.lane + 1];
    for (int it = gw; it < M * 4; it += NGW) {
        const int m = it >> 2, h = it & 3; const int col = h * 128 + 2 * F.lane;
        const float2 o = *(const float2*)(GO + (size_t)m * 512 + col);
        const float ms = wave_sum(o.x * o.x + o.y * o.y) * (1.f / 128.f); const float rs = 1.0f / sqrtf(ms + GLA_EPS);
        const unsigned gw2 = *(const unsigned*)(P + (size_t)m * NP + C_GG + col);
        const float g0 = __uint_as_float(gw2 << 16), g1 = __uint_as_float(gw2 & 0xffff0000u);
        *(unsigned*)(outA + (size_t)m * 512 + col) = pk2(o.x * rs * ng0 * g0 * sigm(g0), o.y * rs * ng1 * g1 * sigm(g1));
    }
}

constexpr int N_PHASES = 2 + 10 * DEPTH;
__global__ void __launch_bounds__(NTHR, 2) mk_fwd(Args args) {
    extern __shared__ __attribute__((aligned(16))) unsigned char lds_raw[];
    Frame F;
    F.lds = (LAS unsigned char*)lds_raw; F.tid = threadIdx.x; F.lane = F.tid & 63; F.wave = __builtin_amdgcn_readfirstlane(F.tid >> 6);
    F.bid = blockIdx.x; F.G = gridDim.x; F.in = args.in; F.out = args.out; F.ws = args.ws;
    volatile LAS unsigned* MISC = (volatile LAS unsigned*)(F.lds + MISC_OFF);
    if (F.tid < 32) MISC[F.tid] = 0u;
    __syncthreads();
    const int lo = args.ph_lo, hi = args.ph_hi;
    XcdBarrier bar; bar.bar = (unsigned*)(F.ws + WS_CTL) + CW_BAR; bar.x = 0; bar.st = nullptr;
    if (hi - lo > 1) bar = xcd_barrier_post((unsigned*)(F.ws + WS_CTL) + CW_BAR, MISC + 8);
#define IN(k) (lo <= (k) && (k) < hi)
#ifndef EN_MASK
#define EN_MASK 0xFFF
#endif
#define EN(i) ((EN_MASK >> (i)) & 1)
#define SEAM(k) do { if (IN(k) && IN((k) + 1)) xcd_barrier(bar); } while (0)
#define PHASE_PTRS() Frame Fl = F; Fl.ws = launder(F.ws); Fl.out = launder(F.out); { int t_ = threadIdx.x; asm volatile("" : "+v"(t_)); Fl.tid = t_; Fl.lane = t_ & 63; Fl.wave = __builtin_amdgcn_readfirstlane(t_ >> 6); } \
    const float* mod = (const float*)(Fl.ws + WS_MOD); bf16* P = (bf16*)(Fl.ws + WS_P); bf16* UB = (bf16*)(Fl.ws + WS_UB); bf16* BR = (bf16*)(Fl.ws + WS_BR); \
    float* H = (float*)(Fl.ws + WS_H); bf16* HID = (bf16*)(Fl.ws + WS_HID); (void)mod; (void)P; (void)UB; (void)BR; (void)H; (void)HID;
    if (IN(0) && EN(0)) { phase_mod(F); } SEAM(0);
    if (IN(1) && EN(1)) { convert_weights(F, 0); make_u0(F); } SEAM(1);
#pragma unroll 1
    for (int l = 0; l < DEPTH; ++l) {
        const int pb = 2 + 10 * l;
        if (IN(pb + 0) && EN(2)) { PHASE_PTRS(); pg8::Gemm g{UB, (const bf16*)(Fl.ws + WS_WIN), M, NP, D}; pg8::StaticOrder S; S.init(M, NP, F.G, F.bid);
            pg8::EpiBf16<0> E{P, NP, nullptr, 0, 0, 1.f};
            pg8::gemm_phase<pg8::EpiBf16<0>, pg8::StaticOrder, true, true>(F.lds, g, S, E); }
        SEAM(pb + 0);
        if (IN(pb + 1) && EN(3)) { PHASE_PTRS(); phase_rwprep(Fl, l); } SEAM(pb + 1);
        if (IN(pb + 2) && EN(4)) { PHASE_PTRS();
            if (F.bid < 16) { if (Fl.wave == 0) rwkv_scan_wave(Fl, l, F.bid); }
            else if (F.bid < 32) { if (Fl.wave == 0) gla_scan_wave(Fl, l, F.bid - 16); }
            else attn_waves(Fl, (F.bid - 32) * NWAVES + Fl.wave, (F.G - 32) * NWAVES);
            __syncthreads();
        }
        SEAM(pb + 2);
        if (IN(pb + 3) && EN(5)) { PHASE_PTRS(); phase_gla_post(Fl, l); } SEAM(pb + 3);
        if (IN(pb + 4) && EN(6)) {
#pragma unroll 1
            for (int n = 0; n < 3; ++n) { PHASE_PTRS(); pg8::Gemm g{BR + (size_t)n * M * 512, (const bf16*)(Fl.ws + WS_WBR) + (size_t)n * 1024 * 512, M, D, 512}; pg8::StaticOrder S; S.init(M, D, F.G, F.bid);
                pg8::EpiBranch E{P + C_GATE + n * 1024, NP, (float*)(Fl.ws + WS_TMP), UB, n};
                pg8::gemm_phase<pg8::EpiBranch, pg8::StaticOrder, false, true>(F.lds, g, S, E);
                asm volatile("s_waitcnt vmcnt(0)" ::: "memory"); __syncthreads(); }
        }
        SEAM(pb + 4);
        if (IN(pb + 5) && EN(7)) { PHASE_PTRS(); pg8::Gemm g{UB, (const bf16*)(Fl.ws + WS_WOUT), M, D, D}; pg8::StaticOrder S; S.init(M, D, F.G, F.bid);
            pg8::EpiF32 E{H, D};
            pg8::gemm_phase<pg8::EpiF32, pg8::StaticOrder, false, true>(F.lds, g, S, E); }
        SEAM(pb + 5);
        if (IN(pb + 6) && EN(8)) { PHASE_PTRS(); const float* xold = (l == 0) ? launder(F.in[I_X]) : (const float*)Fl.out;
            phase_ln(Fl, xold, H, mod + (size_t)l * 2 * 6144 + 2 * 1024, launder(F.in[I_LN1G]) + l * D, launder(F.in[I_LN1B]) + l * D, Fl.out, mod + (size_t)l * 2 * 6144 + 3 * 1024, UB); }
        SEAM(pb + 6);
        if (IN(pb + 7) && EN(9)) { PHASE_PTRS(); pg8::Gemm g{UB, (const bf16*)(Fl.ws + WS_W1), M, 2 * FFH, D}; pg8::StaticOrder S; S.init(M, 2 * FFH, F.G, F.bid);
            pg8::EpiSwiglu E{HID, FFH};
            pg8::gemm_phase<pg8::EpiSwiglu, pg8::StaticOrder, true, true>(F.lds, g, S, E); }
        SEAM(pb + 7);
        if (IN(pb + 8) && EN(10)) { PHASE_PTRS(); pg8::Gemm g{HID, (const bf16*)(Fl.ws + WS_W2), M, D, FFH}; pg8::StaticOrder S; S.init(M, D, F.G, F.bid);
            pg8::EpiF32 E{H, D};
            pg8::gemm_phase<pg8::EpiF32, pg8::StaticOrder, false, true>(F.lds, g, S, E); }
        SEAM(pb + 8);
        if (IN(pb + 9) && EN(11)) { PHASE_PTRS();
            const float* nsh = (l + 1 < DEPTH) ? mod + (size_t)(l + 1) * 2 * 6144 : nullptr;
            phase_ln(Fl, Fl.out, H, mod + (size_t)l * 2 * 6144 + 5 * 1024, launder(F.in[I_LN2G]) + l * D, launder(F.in[I_LN2B]) + l * D, Fl.out, nsh, UB);
            if (l + 1 < DEPTH) convert_weights(Fl, l + 1);
        }
        SEAM(pb + 9);
    }
#undef IN
#undef SEAM
}

extern "C" void kernel_launch(void* const* d_in, const int* in_sizes, int n_in, void* d_out, int out_size, void* d_ws, size_t ws_size, hipStream_t stream) {
    static int grid = 0;
    if (grid == 0) {
        if (n_in != N_IN || in_sizes[0] != M * D || out_size != M * D || ws_size < WS_END) { fprintf(stderr, "kernel_launch: unexpected shapes (n_in %d, in0 %d, out %d, ws %zu, need %zu)\n", n_in, n_in > 0 ? in_sizes[0] : -1, out_size, ws_size, (size_t)WS_END); grid = -1; return; }
        int dev = 0, cus = 0, per_cu = 0;
        if (hipGetDevice(&dev) != hipSuccess || hipDeviceGetAttribute(&cus, hipDeviceAttributeMultiprocessorCount, dev) != hipSuccess) { grid = -1; return; }
        if (hipFuncSetAttribute((const void*)mk_fwd, hipFuncAttributeMaxDynamicSharedMemorySize, LDS_BYTES) != hipSuccess) { fprintf(stderr, "kernel_launch: hipFuncSetAttribute failed\n"); grid = -1; return; }
        if (hipOccupancyMaxActiveBlocksPerMultiprocessor(&per_cu, (const void*)mk_fwd, NTHR, LDS_BYTES) != hipSuccess || per_cu < 1) fprintf(stderr, "kernel_launch: occupancy query says %d\n", per_cu);
        (void)hipGetLastError();
        grid = 256;
        if (cus < 256) { fprintf(stderr, "kernel_launch: %d CUs < 256\n", cus); grid = -1; return; }
    }
    if (grid < 0) return;
    (void)hipMemsetAsync((char*)d_ws + WS_CTL, 0, CTL_ZERO_BYTES, stream);
    Args a{};
    for (int i = 0; i < N_IN; ++i) a.in[i] = (const float*)d_in[i];
    a.out = (float*)d_out; a.ws = (unsigned char*)d_ws;
#if MK_ONE_LAUNCH
    a.ph_lo = 0; a.ph_hi = N_PHASES;
    hipLaunchKernelGGL(mk_fwd, dim3(grid), dim3(NTHR), LDS_BYTES, stream, a);
#else
    for (int k = 0; k < N_PHASES; ++k) { a.ph_lo = k; a.ph_hi = k + 1; hipLaunchKernelGGL(mk_fwd, dim3(grid), dim3(NTHR), LDS_BYTES, stream, a); }
#endif
}
```

```cpp
#ifndef MK_ONE_LAUNCH
#define MK_ONE_LAUNCH 1
#endif
#include <hip/hip_runtime.h>
#include <cstdio>
#include <cstdint>
namespace pg8 {
#define PG8_LAS __attribute__((address_space(3)))
typedef unsigned short bf16_t;
typedef short bf16x8 __attribute__((ext_vector_type(8)));
typedef float f32x4 __attribute__((ext_vector_type(4)));
typedef unsigned u32x4 __attribute__((ext_vector_type(4)));
constexpr int BM = 256, BK = 64, HALF = 128, HTB = HALF * BK * 2  , STAGE_BYTES = 8 * HTB, NXCD = 8, WGM = 8;

__host__ __device__ __forceinline__ int lds_byte(int r, int c) { const int st = (r >> 4) * 2 + (c >> 5), rr = r & 15, cc = c & 31, ob = rr * 64 + cc * 2; return st * 1024 + (ob ^ (((ob >> 9) & 1) << 5)); }
__host__ __device__ __forceinline__ void stage_rc(int b, int& R, int& C) { const int st = b / 1024, sb = b % 1024, swz = sb ^ (((sb >> 9) & 1) << 5); R = (st >> 1) * 16 + swz / 64; C = (st & 1) * 32 + (swz % 64) / 2; }
__host__ __device__ __forceinline__ int perm32(int rho) { const int n = rho >> 4, i = rho & 15; return 8 * (i >> 2) + 4 * n + (i & 3); }

struct Unit { int pm, pn; };
struct Gemm { const bf16_t* A; const bf16_t* Bt; int M, N, K; };

struct StaticOrder {
    int nM, nN, nwg, G, c;
    __host__ __device__ void init(int M, int N, int G_, int c_) { nM = M / BM; nN = N / BM; nwg = nM * nN; G = G_; c = c_; }
    __host__ __device__ bool next(int i, Unit& u) const {
        const long L = (long)i * G + c; if (L >= nwg) return false;
        int wgid = (int)L; { const int q = nwg / NXCD, r = nwg % NXCD, xcd = wgid % NXCD, off = wgid / NXCD; wgid = (xcd < r ? xcd * (q + 1) : r * (q + 1) + (xcd - r) * q) + off; }
        const int nig = WGM * nN, gid = wgid / nig, fm = gid * WGM, gsz = (nM - fm) < WGM ? (nM - fm) : WGM;
        u.pm = fm + ((wgid % nig) % gsz); u.pn = (wgid % nig) / gsz; return true;
    }
    __device__ __forceinline__ void a_ready(const Unit&) const {}
    __device__ __forceinline__ void done(const Unit&) const {}
};

__device__ __forceinline__ unsigned cvt_pk_bf16(float lo, float hi) { unsigned r; asm volatile("v_cvt_pk_bf16_f32 %0, %1, %2" : "=v"(r) : "v"(lo), "v"(hi)); return r; }
typedef float f32x2 __attribute__((ext_vector_type(2)));
__device__ __forceinline__ f32x2 gelu_pk(f32x2 v) {
    const f32x2 av = __builtin_elementwise_abs(v), d = av * 0.2316418882f + 1.0f;
    f32x2 t; t.x = __builtin_amdgcn_rcpf(d.x); t.y = __builtin_amdgcn_rcpf(d.y);
    f32x2 q = t * 0.5307027145f + (-0.7265760135f); q = q * t + 0.7107068705f; q = q * t + (-0.142248368f); q = q * t + 0.127414796f; q = q * t;
    const f32x2 s = (v * v) * (-0.72134752044f);
    f32x2 e; e.x = __builtin_amdgcn_exp2f(s.x); e.y = __builtin_amdgcn_exp2f(s.y);
    const f32x2 m = v * (q * e), r = v - m;
    f32x2 o; o.x = v.x < 0.f ? m.x : r.x; o.y = v.y < 0.f ? m.y : r.y; return o;
}

template <int ACT  > struct EpiBf16 {
    static constexpr bool PERM = true, AFTER_DRAIN = false; static_assert(ACT == 0 || ACT == 1, "EpiBf16: ACT is 0 (none) or 1 (gelu_pk)");
    bf16_t* O; int ldc; const float* bias; int split_cols; size_t split_stride; float scale0;
    __device__ __forceinline__ void operator()(const f32x4 (&acc)[2][2][4][2], const Unit& u, int wr, int wc, int fr, int fq) const {
        const int row0 = u.pm * BM + wr * 64 + fr; int colt = u.pn * BM; bf16_t* base = O;
        float sc = 1.f; if (split_cols) { const int t = colt / split_cols; base += (size_t)t * split_stride; colt -= t * split_cols; if (t == 0) sc = scale0; }
        const int col0 = colt + wc * 32 + 8 * fq, bcol0 = u.pn * BM + wc * 32 + 8 * fq;
        f32x4 bv[2][2];
#pragma unroll
        for (int bj = 0; bj < 2; ++bj)
#pragma unroll
            for (int n = 0; n < 2; ++n) bv[bj][n] = bias ? *(const f32x4*)(bias + bcol0 + bj * HALF + 4 * n) : (f32x4){0.f, 0.f, 0.f, 0.f};
#pragma unroll
        for (int ai = 0; ai < 2; ++ai)
#pragma unroll
            for (int m = 0; m < 4; ++m) { bf16_t* rowp = base + (size_t)(row0 + ai * HALF + m * 16) * ldc + col0;
#pragma unroll
                for (int bj = 0; bj < 2; ++bj) { f32x4 v0 = acc[ai][bj][m][0] + bv[bj][0], v1 = acc[ai][bj][m][1] + bv[bj][1];
                    if (ACT == 1) { f32x2 a = gelu_pk((f32x2){v0[0], v0[1]}), b = gelu_pk((f32x2){v0[2], v0[3]}), c = gelu_pk((f32x2){v1[0], v1[1]}), d = gelu_pk((f32x2){v1[2], v1[3]});
                        v0 = (f32x4){a.x, a.y, b.x, b.y}; v1 = (f32x4){c.x, c.y, d.x, d.y}; }
                    v0 = v0 * sc; v1 = v1 * sc; u32x4 w; w.x = cvt_pk_bf16(v0[0], v0[1]); w.y = cvt_pk_bf16(v0[2], v0[3]); w.z = cvt_pk_bf16(v1[0], v1[1]); w.w = cvt_pk_bf16(v1[2], v1[3]);
                    *(u32x4*)(rowp + bj * HALF) = w; } }
    }
};

struct PanelStats {
    unsigned* xbuf;
    unsigned* cnt;
    unsigned* tmo;
    int ntn; float eps;
    unsigned code;
    __device__ __forceinline__ bool run(const f32x4 (&v)[2][2][4][2], const Unit& u, int wr, int wc, int fr, int fq, PG8_LAS unsigned char* lds, int wid, int lane) const {
        typedef float f32x2v __attribute__((ext_vector_type(2)));
        PG8_LAS f32x2v* P = (PG8_LAS f32x2v*)lds;
        PG8_LAS f32x2v* S = (PG8_LAS f32x2v*)(lds + 8192);
        PG8_LAS unsigned* flag = (PG8_LAS unsigned*)(lds + 8192 + 2048);
#pragma unroll
        for (int ai = 0; ai < 2; ++ai)
#pragma unroll
            for (int m = 0; m < 4; ++m) {
                float s = 0.f;
#pragma unroll
                for (int bj = 0; bj < 2; ++bj)
#pragma unroll
                    for (int n = 0; n < 2; ++n) { const f32x4 x = v[ai][bj][m][n]; s += (x[0] + x[1]) + (x[2] + x[3]); }
                s += __shfl_xor(s, 16); s += __shfl_xor(s, 32);
                const float mw = s * (1.0f / 64.0f); float q = 0.f;
#pragma unroll
                for (int bj = 0; bj < 2; ++bj)
#pragma unroll
                    for (int n = 0; n < 2; ++n) { const f32x4 d = v[ai][bj][m][n] - mw; q += (d[0] * d[0] + d[1] * d[1]) + (d[2] * d[2] + d[3] * d[3]); }
                q += __shfl_xor(q, 16); q += __shfl_xor(q, 32);
                if (fq == 0) P[(ai * HALF + wr * 64 + m * 16 + fr) * 4 + wc] = (f32x2v){mw, q};
            }
        asm volatile("s_waitcnt lgkmcnt(0)" ::: "memory"); __builtin_amdgcn_s_barrier(); asm volatile("" ::: "memory");
#if defined(BROKEN_EXCHANGE_NO_WAIT)
#warning BROKEN CONTROL BUILD: the row-statistics exchange does not wait; results are wrong by design
        if (blockIdx.x >= 64) { const long long t0_ = clock64(); while (clock64() - t0_ < 60000) __builtin_amdgcn_s_sleep(8); }
#endif
        const int row = wid * 32 + (lane & 31);
        if (lane < 32) {
            const f32x2v a = P[row * 4 + 0], b = P[row * 4 + 1], c = P[row * 4 + 2], d = P[row * 4 + 3];
            const float mt = (a.x + b.x + c.x + d.x) * 0.25f;
            const float da = a.x - mt, db = b.x - mt, dc = c.x - mt, dd = d.x - mt;
            const float m2 = (a.y + b.y) + (c.y + d.y) + 64.0f * ((da * da + db * db) + (dc * dc + dd * dd));
            unsigned long long* slot = (unsigned long long*)xbuf + ((size_t)(u.pm * BM + row) * 4 + u.pn);
            __hip_atomic_store(slot, ((unsigned long long)__float_as_uint(m2) << 32) | __float_as_uint(mt), __ATOMIC_RELAXED, __HIP_MEMORY_SCOPE_AGENT);
        }
        asm volatile("s_waitcnt vmcnt(0)" ::: "memory");
        if (lane == 0) __hip_atomic_fetch_add(cnt + 64 * u.pm, 1u, __ATOMIC_RELAXED, __HIP_MEMORY_SCOPE_AGENT);
        if (wid == 0) {
            bool dead = false; const unsigned long long t0 = __builtin_amdgcn_s_memrealtime(); const unsigned want = 8u * (unsigned)ntn;
            for (;;) {
#if defined(BROKEN_EXCHANGE_NO_WAIT)
                break;
#endif
                if ((unsigned)__builtin_amdgcn_readfirstlane(__hip_atomic_load(cnt + 64 * u.pm, __ATOMIC_RELAXED, __HIP_MEMORY_SCOPE_AGENT)) >= want) break;
                if (__builtin_amdgcn_s_memrealtime() - t0 > 2000000ull) {
                    if (lane == 0) { unsigned expect = 0u; __hip_atomic_compare_exchange_strong(tmo + 1, &expect, code | (unsigned)(u.pm & 0xff), __ATOMIC_RELAXED, __ATOMIC_RELAXED, __HIP_MEMORY_SCOPE_AGENT);
                                     __hip_atomic_store(tmo, 1u, __ATOMIC_RELAXED, __HIP_MEMORY_SCOPE_AGENT); }
                    dead = true; break; }
                __builtin_amdgcn_s_sleep(2);
            }
            __builtin_amdgcn_fence(__ATOMIC_ACQUIRE, "agent");
            if (lane == 0) flag[0] = dead ? 1u : 0u;
        }
        asm volatile("s_waitcnt vmcnt(0) lgkmcnt(0)" ::: "memory"); __builtin_amdgcn_s_barrier(); asm volatile("" ::: "memory");
        const bool bad = flag[0] != 0u;
        if (lane < 32) {
            const unsigned long long* slot = (const unsigned long long*)xbuf + (size_t)(u.pm * BM + row) * 4; float mt[4], m2[4]; float ms = 0.f;
#pragma unroll
            for (int t = 0; t < 4; ++t) { if (t < ntn) { const unsigned long long w = __hip_atomic_load(slot + t, __ATOMIC_RELAXED, __HIP_MEMORY_SCOPE_AGENT); mt[t] = __uint_as_float((unsigned)w); m2[t] = __uint_as_float((unsigned)(w >> 32)); } else { mt[t] = 0.f; m2[t] = 0.f; } ms += mt[t]; }
            const float mean = ms / (float)ntn; float q = 0.f;
#pragma unroll
            for (int t = 0; t < 4; ++t) if (t < ntn) { const float dm = mt[t] - mean; q += m2[t] + 256.0f * dm * dm; }
            S[row] = (f32x2v){mean, 1.0f / sqrtf(q / (256.0f * (float)ntn) + eps)};
        }
        asm volatile("s_waitcnt lgkmcnt(0)" ::: "memory"); __builtin_amdgcn_s_barrier(); asm volatile("" ::: "memory");
        return bad;
    }
};
struct EpiLnRes {
    static constexpr bool PERM = false, AFTER_DRAIN = true;
    const float* base; float* out; int ldc; const float* bias; PanelStats st; unsigned poison;
    __device__ __forceinline__ void fused(f32x4 (&acc)[2][2][4][2], const Unit& u, int wr, int wc, int fr, int fq, PG8_LAS unsigned char* lds, int wid, int lane) const {
        typedef float f32x2v __attribute__((ext_vector_type(2)));
        const PG8_LAS f32x2v* S = (const PG8_LAS f32x2v*)(lds + 8192);
        const int col0 = u.pn * BM + wc * 32 + 4 * fq;
#pragma unroll
        for (int bj = 0; bj < 2; ++bj)
#pragma unroll
            for (int n = 0; n < 2; ++n) { const f32x4 bv = bias ? *(const f32x4*)(bias + col0 + bj * HALF + n * 16) : (f32x4){0.f, 0.f, 0.f, 0.f};
#pragma unroll
                for (int ai = 0; ai < 2; ++ai)
#pragma unroll
                    for (int m = 0; m < 4; ++m) acc[ai][bj][m][n] += bv; }
        f32x4 pre[4][2][2];
#pragma unroll
        for (int m = 0; m < 4; ++m) { const size_t off = (size_t)(u.pm * BM + wr * 64 + m * 16 + fr) * ldc + col0;
#pragma unroll
            for (int bj = 0; bj < 2; ++bj)
#pragma unroll
                for (int n = 0; n < 2; ++n) pre[m][bj][n] = *(const f32x4*)(base + off + bj * HALF + n * 16); }
        const bool bad = st.run(acc, u, wr, wc, fr, fq, lds, wid, lane) || poison != 0u;
        const float qnan = __builtin_nanf("");
#pragma unroll
        for (int ai = 0; ai < 2; ++ai)
#pragma unroll
            for (int m = 0; m < 4; ++m) { const int r = ai * HALF + wr * 64 + m * 16 + fr; const f32x2v sr = S[r]; const size_t off = (size_t)(u.pm * BM + r) * ldc + col0;
#pragma unroll
                for (int bj = 0; bj < 2; ++bj)
#pragma unroll
                    for (int n = 0; n < 2; ++n) { const f32x4 bs = ai == 0 ? pre[m][bj][n] : *(const f32x4*)(base + off + bj * HALF + n * 16); f32x4 o = bs + (acc[ai][bj][m][n] - sr.x) * sr.y;
                        if (bad) o = (f32x4){qnan, qnan, qnan, qnan}; *(f32x4*)(out + off + bj * HALF + n * 16) = o; }
                if (m & 1) asm volatile("" ::: "memory"); }
    }
};
struct EpiLnResLn {
    static constexpr bool PERM = false, AFTER_DRAIN = true;
    const float* base; float* out; bf16_t* xn; int ldc; const float* bias; PanelStats st1, st2; unsigned poison;
    __device__ __forceinline__ void fused(f32x4 (&acc)[2][2][4][2], const Unit& u, int wr, int wc, int fr, int fq, PG8_LAS unsigned char* lds, int wid, int lane) const {
        typedef float f32x2v __attribute__((ext_vector_type(2))); typedef unsigned u32x2v __attribute__((ext_vector_type(2)));
        const PG8_LAS f32x2v* S = (const PG8_LAS f32x2v*)(lds + 8192);
        const int col0 = u.pn * BM + wc * 32 + 4 * fq;
#pragma unroll
        for (int bj = 0; bj < 2; ++bj)
#pragma unroll
            for (int n = 0; n < 2; ++n) { const f32x4 bv = bias ? *(const f32x4*)(bias + col0 + bj * HALF + n * 16) : (f32x4){0.f, 0.f, 0.f, 0.f};
#pragma unroll
                for (int ai = 0; ai < 2; ++ai)
#pragma unroll
                    for (int m = 0; m < 4; ++m) acc[ai][bj][m][n] += bv; }
        bool bad = st1.run(acc, u, wr, wc, fr, fq, lds, wid, lane) || poison != 0u;
        const float qnan = __builtin_nanf("");
#pragma unroll
        for (int ai = 0; ai < 2; ++ai)
#pragma unroll
            for (int m = 0; m < 4; ++m) { const int r = ai * HALF + wr * 64 + m * 16 + fr; const f32x2v sr = S[r]; const size_t off = (size_t)(u.pm * BM + r) * ldc + col0;
#pragma unroll
                for (int bj = 0; bj < 2; ++bj)
#pragma unroll
                    for (int n = 0; n < 2; ++n) { const f32x4 bs = *(const f32x4*)(base + off + bj * HALF + n * 16); acc[ai][bj][m][n] = bs + (acc[ai][bj][m][n] - sr.x) * sr.y; }
                asm volatile("" : "+v"(acc[ai][0][m][0]), "+v"(acc[ai][0][m][1]), "+v"(acc[ai][1][m][0]), "+v"(acc[ai][1][m][1]));
                if (m & 1) asm volatile("" ::: "memory"); }
        const bool bad1 = bad;
        bad = st2.run(acc, u, wr, wc, fr, fq, lds, wid, lane) || bad;
#pragma unroll
        for (int ai = 0; ai < 2; ++ai)
#pragma unroll
            for (int m = 0; m < 4; ++m) { const int r = ai * HALF + wr * 64 + m * 16 + fr; const f32x2v sr = S[r]; const size_t off = (size_t)(u.pm * BM + r) * ldc + col0;
#pragma unroll
                for (int bj = 0; bj < 2; ++bj)
#pragma unroll
                    for (int n = 0; n < 2; ++n) { const f32x4 x1 = acc[ai][bj][m][n]; *(f32x4*)(out + off + bj * HALF + n * 16) = bad1 ? (f32x4){qnan, qnan, qnan, qnan} : x1;
                        const f32x4 o = (x1 - sr.x) * sr.y; u32x2v w; w.x = cvt_pk_bf16(o[0], o[1]); w.y = cvt_pk_bf16(o[2], o[3]);
                        if (bad) { w.x = 0x7fc07fc0u; w.y = 0x7fc07fc0u; } *(u32x2v*)(xn + off + bj * HALF + n * 16) = w; }
                asm volatile("" ::: "memory"); }
    }
};

template <class Epi, class Sched, bool ALIGN_EPI = false, bool SP2 = false>
__device__ __forceinline__ void gemm_phase(PG8_LAS unsigned char* lds, const Gemm g, const Sched& S, const Epi& E) {
    int tid_ = threadIdx.x; asm volatile("" : "+v"(tid_));
    const int tid = tid_, wid = __builtin_amdgcn_readfirstlane(tid >> 6), lane = tid & 63, wr = wid >> 2, wc = wid & 3, fr = lane & 15, fq = lane >> 4;
    const int K = g.K, nt = K / BK;
    unsigned voffA[2], voffB[2];
#pragma unroll
    for (int i = 0; i < 2; ++i) { int R, C; stage_rc(tid * 16 + i * 8192, R, C); const int Rb = Epi::PERM ? ((R & ~31) + perm32(R & 31)) : R;
        voffA[i] = (unsigned)(R * K + C) * 2u; voffB[i] = (unsigned)(Rb * K + C) * 2u; }
    const size_t kstep = (size_t)(BK * 2);
    const size_t hstep = (size_t)HALF * K * 2;
    const size_t tstep = 2 * hstep;
    const unsigned ldsw = (unsigned)wid * 1024u;
    const int aoff = lds_byte(wr * 64 + fr, fq * 8), boff = lds_byte(wc * 32 + fr, fq * 8);
#define PG8_SA(b, h) (((b) * 2 + (h)) * HTB)
#define PG8_SB(b, h) ((4 + (b) * 2 + (h)) * HTB)
#define PG8_STAGE(bufoff, gbase, voff) do { _Pragma("unroll") for (int _i = 0; _i < 2; ++_i) \
        __builtin_amdgcn_global_load_lds((const unsigned*)((const char*)(gbase) + (voff)[_i]), (PG8_LAS unsigned*)(lds + (bufoff) + ldsw + _i * 8192), 16, 0, 0); } while (0)
#define PG8_LDA(dst, b, h) do { _Pragma("unroll") for (int m = 0; m < 4; ++m) _Pragma("unroll") for (int k = 0; k < 2; ++k) dst[m][k] = *(const PG8_LAS bf16x8*)(lds + PG8_SA(b, h) + aoff + m * 2048 + k * 1024); } while (0)
#define PG8_LDB(dst, b, h) do { _Pragma("unroll") for (int n = 0; n < 2; ++n) _Pragma("unroll") for (int k = 0; k < 2; ++k) dst[n][k] = *(const PG8_LAS bf16x8*)(lds + PG8_SB(b, h) + boff + n * 2048 + k * 1024); } while (0)
#define PG8_MMA(ai, bj, At, Bt) do { __builtin_amdgcn_s_setprio(1); _Pragma("unroll") for (int m = 0; m < 4; ++m) _Pragma("unroll") for (int n = 0; n < 2; ++n) _Pragma("unroll") for (int k = 0; k < 2; ++k) \
        acc[ai][bj][m][n] = __builtin_amdgcn_mfma_f32_16x16x32_bf16(Bt[n][k], At[m][k], acc[ai][bj][m][n], 0, 0, 0); __builtin_amdgcn_s_setprio(0); } while (0)
#define PG8_WAIT_V(n) asm volatile("s_waitcnt vmcnt(" #n ")" ::: "memory")
#define PG8_WAIT_L(n) asm volatile("s_waitcnt lgkmcnt(" #n ")" ::: "memory")
#define PG8_BAR __builtin_amdgcn_s_barrier()
#define PG8_SCHED __builtin_amdgcn_sched_barrier(0)
    Unit cur, nxt; int ui = 0;
    if (!S.next(0, cur)) return;
    f32x4 acc[2][2][4][2];
#pragma unroll
    for (int a = 0; a < 2; ++a)
#pragma unroll
        for (int b = 0; b < 2; ++b)
#pragma unroll
            for (int m = 0; m < 4; ++m)
#pragma unroll
                for (int n = 0; n < 2; ++n) acc[a][b][m][n] = (f32x4){0.f, 0.f, 0.f, 0.f};
    bf16x8 At[4][2], B0[2][2], B1[2][2];
    const char* cA = (const char*)g.A + (size_t)cur.pm * tstep; const char* cB = (const char*)g.Bt + (size_t)cur.pn * tstep;
    S.a_ready(cur);
    if constexpr (SP2) {
        PG8_STAGE(PG8_SB(0, 0), cB, voffB); PG8_STAGE(PG8_SB(0, 1), cB + hstep, voffB); PG8_STAGE(PG8_SA(0, 0), cA, voffA); PG8_STAGE(PG8_SA(0, 1), cA + hstep, voffA);
        if (wr == 1) PG8_BAR;
        PG8_WAIT_V(2); PG8_BAR;
        PG8_STAGE(PG8_SB(1, 0), cB + kstep, voffB); PG8_STAGE(PG8_SA(1, 0), cA + kstep, voffA); PG8_STAGE(PG8_SB(1, 1), cB + hstep + kstep, voffB);
        PG8_WAIT_V(6); PG8_BAR;
    } else {
        PG8_STAGE(PG8_SB(0, 0), cB, voffB); PG8_STAGE(PG8_SA(0, 0), cA, voffA); PG8_STAGE(PG8_SB(0, 1), cB + hstep, voffB); PG8_STAGE(PG8_SA(0, 1), cA + hstep, voffA);
        if (wr == 1) PG8_BAR;
        PG8_WAIT_V(4); PG8_BAR;
        PG8_STAGE(PG8_SB(1, 0), cB + kstep, voffB); PG8_STAGE(PG8_SA(1, 0), cA + kstep, voffA); PG8_STAGE(PG8_SB(1, 1), cB + hstep + kstep, voffB);
        PG8_WAIT_V(6); PG8_BAR;
    }
    for (;;) {
        const bool has_next = S.next(ui + 1, nxt);
        const char* nA = has_next ? (const char*)g.A + (size_t)nxt.pm * tstep : cA; const char* nB = has_next ? (const char*)g.Bt + (size_t)nxt.pn * tstep : cB;
        for (int t = 0; t < nt; t += 2) {
            const bool last = (t == nt - 2);
            const char* a1 = cA + (size_t)(t + 1) * kstep;
            const char* a2 = last ? nA : cA + (size_t)(t + 2) * kstep; const char* b2 = last ? nB : cB + (size_t)(t + 2) * kstep;
            const char* a3 = a2 + kstep; const char* b3 = b2 + kstep;
            if (last && has_next) S.a_ready(nxt);
            if constexpr (SP2) {
            PG8_LDB(B0, 0, 0); PG8_LDB(B1, 0, 1); PG8_SCHED; PG8_LDA(At, 0, 0); PG8_STAGE(PG8_SA(1, 1), a1 + hstep, voffA);
            PG8_WAIT_V(8); PG8_WAIT_L(0); PG8_BAR; PG8_MMA(0, 0, At, B0); PG8_MMA(0, 1, At, B1); PG8_BAR; PG8_SCHED;
            PG8_LDA(At, 0, 1); PG8_STAGE(PG8_SB(0, 0), b2, voffB); PG8_STAGE(PG8_SB(0, 1), b2 + hstep, voffB); PG8_STAGE(PG8_SA(0, 0), a2, voffA);
            PG8_WAIT_V(8); PG8_WAIT_L(0); PG8_BAR; PG8_MMA(1, 0, At, B0); PG8_MMA(1, 1, At, B1); PG8_BAR; PG8_SCHED;
            PG8_LDB(B0, 1, 0); PG8_LDB(B1, 1, 1); PG8_SCHED; PG8_LDA(At, 1, 0); PG8_STAGE(PG8_SA(0, 1), a2 + hstep, voffA);
            PG8_WAIT_V(8); PG8_WAIT_L(0); PG8_BAR; PG8_MMA(0, 0, At, B0); PG8_MMA(0, 1, At, B1); PG8_BAR; PG8_SCHED;
            PG8_LDA(At, 1, 1); PG8_STAGE(PG8_SB(1, 0), b3, voffB); PG8_STAGE(PG8_SB(1, 1), b3 + hstep, voffB); PG8_STAGE(PG8_SA(1, 0), a3, voffA);
            PG8_WAIT_V(8); PG8_WAIT_L(0); PG8_BAR; PG8_MMA(1, 0, At, B0); PG8_MMA(1, 1, At, B1); PG8_BAR; PG8_SCHED;
            } else {
            PG8_LDB(B0, 0, 0); PG8_SCHED; PG8_LDA(At, 0, 0); PG8_STAGE(PG8_SA(1, 1), a1 + hstep, voffA);
            PG8_WAIT_L(8); PG8_BAR; PG8_WAIT_L(0); PG8_MMA(0, 0, At, B0); PG8_BAR; PG8_SCHED;
            PG8_LDB(B1, 0, 1); PG8_STAGE(PG8_SB(0, 0), b2, voffB);
            PG8_BAR; PG8_WAIT_L(0); PG8_MMA(0, 1, At, B1); PG8_BAR;
            PG8_LDA(At, 0, 1); PG8_STAGE(PG8_SA(0, 0), a2, voffA);
            PG8_BAR; PG8_WAIT_L(0); PG8_MMA(1, 0, At, B0); PG8_BAR; PG8_SCHED;
            PG8_STAGE(PG8_SB(0, 1), b2 + hstep, voffB);
            PG8_WAIT_V(6); PG8_BAR; PG8_MMA(1, 1, At, B1); PG8_BAR;
            PG8_LDB(B0, 1, 0); PG8_SCHED; PG8_LDA(At, 1, 0); PG8_STAGE(PG8_SA(0, 1), a2 + hstep, voffA);
            PG8_WAIT_L(8); PG8_BAR; PG8_WAIT_L(0); PG8_MMA(0, 0, At, B0); PG8_BAR; PG8_SCHED;
            PG8_LDB(B1, 1, 1); PG8_STAGE(PG8_SB(1, 0), b3, voffB);
            PG8_BAR; PG8_WAIT_L(0); PG8_MMA(0, 1, At, B1); PG8_BAR;
            PG8_LDA(At, 1, 1); PG8_STAGE(PG8_SA(1, 0), a3, voffA);
            PG8_BAR; PG8_WAIT_L(0); PG8_MMA(1, 0, At, B0); PG8_BAR; PG8_SCHED;
            PG8_STAGE(PG8_SB(1, 1), b3 + hstep, voffB);
            PG8_WAIT_V(6); PG8_BAR; PG8_MMA(1, 1, At, B1); PG8_BAR;
            }
        }
        if constexpr (ALIGN_EPI) { if (wr == 0) PG8_BAR; }
        if constexpr (!Epi::AFTER_DRAIN) { E(acc, cur, wr, wc, fr, fq); S.done(cur); }
        if (!has_next) break;
#pragma unroll
        for (int a = 0; a < 2; ++a)
#pragma unroll
            for (int b = 0; b < 2; ++b)
#pragma unroll
                for (int m = 0; m < 4; ++m)
#pragma unroll
                    for (int n = 0; n < 2; ++n) acc[a][b][m][n] = (f32x4){0.f, 0.f, 0.f, 0.f};
        cur = nxt; cA = nA; cB = nB; ++ui;
        if constexpr (ALIGN_EPI) { if (wr == 1) PG8_BAR; }
    }
    PG8_WAIT_V(0);
    if constexpr (!ALIGN_EPI) { if (wr == 0) PG8_BAR; }
    PG8_BAR;
    if constexpr (Epi::AFTER_DRAIN) { E.fused(acc, cur, wr, wc, fr, fq, lds, wid, lane); S.done(cur); }
#undef PG8_SA
#undef PG8_SB
#undef PG8_STAGE
#undef PG8_LDA
#undef PG8_LDB
#undef PG8_MMA
#undef PG8_WAIT_V
#undef PG8_WAIT_L
#undef PG8_BAR
#undef PG8_SCHED
}
}

namespace pg8 {
__device__ __forceinline__ float bf2f(unsigned short b) { return __uint_as_float(((unsigned)b) << 16); }
__device__ __forceinline__ float sigmoidf_(float x) { return 1.0f / (1.0f + __expf(-x)); }
struct EpiF32 {
    static constexpr bool PERM = false, AFTER_DRAIN = false;
    float* C; int ldc;
    __device__ __forceinline__ void operator()(const f32x4 (&acc)[2][2][4][2], const Unit& u, int wr, int wc, int fr, int fq) const {
        const int row0 = u.pm * BM + wr * 64 + fr, col0 = u.pn * BM + wc * 32 + 4 * fq;
#pragma unroll
        for (int ai = 0; ai < 2; ++ai)
#pragma unroll
            for (int m = 0; m < 4; ++m) { float* rowp = C + (size_t)(row0 + ai * HALF + m * 16) * ldc + col0;
#pragma unroll
                for (int bj = 0; bj < 2; ++bj)
#pragma unroll
                    for (int n = 0; n < 2; ++n) *(f32x4*)(rowp + bj * HALF + n * 16) = acc[ai][bj][m][n]; }
    }
};
struct EpiBranch {
    static constexpr bool PERM = false, AFTER_DRAIN = false;
    const bf16_t* gate; int ldg; float* tmp; bf16_t* out; int mode;
    __device__ __forceinline__ void operator()(const f32x4 (&acc)[2][2][4][2], const Unit& u, int wr, int wc, int fr, int fq) const {
        const int row0 = u.pm * BM + wr * 64 + fr, col0 = u.pn * BM + wc * 32 + 4 * fq;
#pragma unroll
        for (int ai = 0; ai < 2; ++ai)
#pragma unroll
            for (int m = 0; m < 4; ++m) { const size_t r = (size_t)(row0 + ai * HALF + m * 16);
#pragma unroll
                for (int bj = 0; bj < 2; ++bj)
#pragma unroll
                    for (int n = 0; n < 2; ++n) { const int c = col0 + bj * HALF + n * 16;
                        const uint2 gw = *(const uint2*)(gate + r * ldg + c);
                        f32x4 g; g[0] = sigmoidf_(__uint_as_float(gw.x << 16)); g[1] = sigmoidf_(__uint_as_float(gw.x & 0xffff0000u)); g[2] = sigmoidf_(__uint_as_float(gw.y << 16)); g[3] = sigmoidf_(__uint_as_float(gw.y & 0xffff0000u));
                        f32x4 v = g * acc[ai][bj][m][n];
                        float* tp = tmp + r * 1024 + c;
                        if (mode == 0) { *(f32x4*)tp = v; }
                        else if (mode == 1) { *(f32x4*)tp = *(const f32x4*)tp + v; }
                        else { v = *(const f32x4*)tp + v; uint2 w; w.x = cvt_pk_bf16(v[0], v[1]); w.y = cvt_pk_bf16(v[2], v[3]); *(uint2*)(out + r * 1024 + c) = w; } } }
    }
};
struct EpiSwiglu {
    static constexpr bool PERM = true, AFTER_DRAIN = false;
    bf16_t* O; int ldc;
    __device__ __forceinline__ void operator()(const f32x4 (&acc)[2][2][4][2], const Unit& u, int wr, int wc, int fr, int fq) const {
        const int row0 = u.pm * BM + wr * 64 + fr, col0 = u.pn * HALF + wc * 32 + 8 * fq;
#pragma unroll
        for (int ai = 0; ai < 2; ++ai)
#pragma unroll
            for (int m = 0; m < 4; ++m) { bf16_t* rowp = O + (size_t)(row0 + ai * HALF + m * 16) * ldc + col0;
                float h[8];
#pragma unroll
                for (int n = 0; n < 2; ++n)
#pragma unroll
                    for (int i = 0; i < 4; ++i) { const float g = acc[ai][0][m][n][i], up = acc[ai][1][m][n][i]; h[n * 4 + i] = g * sigmoidf_(g) * up; }
                u32x4 w; w.x = cvt_pk_bf16(h[0], h[1]); w.y = cvt_pk_bf16(h[2], h[3]); w.z = cvt_pk_bf16(h[4], h[5]); w.w = cvt_pk_bf16(h[6], h[7]);
                *(u32x4*)rowp = w; }
    }
};
}

constexpr int BATCH = 2, SEQ = 8192, D = 1024, M = BATCH * SEQ, DEPTH = 4;
constexpr int NP = 8192;
constexpr int FFH = 2816;
constexpr int C_ATQ = 0, C_ATK = 512, C_ATV = 1024, C_GQ = 1536, C_GK = 1792, C_GV = 2048, C_GG = 2560;
constexpr int C_RR = 3072, C_RK = 3584, C_RV = 4096, C_RLO = 4608  , C_GA = 4864, C_GATE = 5120;
constexpr float LN_EPS = 1e-5f, GLA_EPS = 1e-5f, GN_EPS = 64e-5f;
constexpr float DN_ALPHA = 1.6817928305074290861f;

constexpr size_t MiB = 1u << 20;
constexpr size_t WS_CTL = 0, CTL_ZERO_BYTES = 1 * MiB;
constexpr size_t WS_MOD = 1 * MiB;
constexpr size_t WS_WIN = 2 * MiB;
constexpr size_t WS_WBR = WS_WIN + 16 * MiB;
constexpr size_t WS_WOUT = WS_WBR + 3 * MiB;
constexpr size_t WS_W1 = WS_WOUT + 2 * MiB;
constexpr size_t WS_W2 = WS_W1 + 11 * MiB;
constexpr size_t WS_LSE = 1 * MiB + 256 * 1024;
constexpr size_t WS_GDEC = 1 * MiB + 768 * 1024;
constexpr size_t WS_UB = 40 * MiB;
constexpr size_t WS_PM = WS_UB;
constexpr size_t WS_BR = WS_UB + 32 * MiB;
constexpr size_t WS_RW = WS_BR + 48 * MiB;
constexpr size_t WS_QS = WS_RW + 48 * MiB;
constexpr size_t WS_DS = WS_QS + 32 * MiB;
constexpr size_t WS_GO = WS_DS;
constexpr size_t WS_TMP = WS_RW;
constexpr size_t WS_P = WS_DS + 32 * MiB;
constexpr size_t WS_H = WS_P;
constexpr size_t WS_HID = WS_P + 64 * MiB;
constexpr size_t WS_END = WS_P + 256 * MiB;
static_assert(WS_W2 + (size_t)1024 * 2816 * 2 <= WS_UB, "weights fit");
constexpr int CW_BAR = 4096;

#define LAS __attribute__((address_space(3)))
typedef unsigned short bf16;
typedef float f32x4 __attribute__((ext_vector_type(4)));
typedef unsigned v4u __attribute__((ext_vector_type(4)));
__device__ __forceinline__ float bf2f(bf16 b) { return __uint_as_float(((unsigned)b) << 16); }
__device__ __forceinline__ unsigned f2bf(float f) { unsigned u = __float_as_uint(f); return (u + 0x7fffu + ((u >> 16) & 1u)) >> 16; }
__device__ __forceinline__ unsigned pk2(float lo, float hi) { return f2bf(lo) | (f2bf(hi) << 16); }
__device__ __forceinline__ float sigm(float x) { return 1.0f / (1.0f + __expf(-x)); }
__device__ __forceinline__ float softplusf_(float x) { return fmaxf(x, 0.f) + log1pf(__expf(-fabsf(x))); }
__device__ __forceinline__ float wave_sum(float v) {
#pragma unroll
    for (int o = 1; o < 64; o <<= 1) v += __shfl_xor(v, o);
    return v;
}
__device__ __forceinline__ float wave_max(float v) {
#pragma unroll
    for (int o = 1; o < 64; o <<= 1) v = fmaxf(v, __shfl_xor(v, o));
    return v;
}
#define LDS_WAIT() asm volatile("s_waitcnt lgkmcnt(0)" ::: "memory")
template <class T> __device__ __forceinline__ T* launder(T* p) { __attribute__((address_space(1))) T* g = (__attribute__((address_space(1))) T*)p; asm volatile("" : "+s"(g)); return (T*)g; }

#define XB_TMO      128
#define XB_XCNT(j)  (256  + 64 * (j))
#define XB_XSUB(j)  (1280 + 64 * (j))
#define XB_XGEN(j)  (2304 + 64 * (j))
#define XB_TOP      3328
#define XB_TOPGEN   3392
#define XCD_BAR_WORDS 3456
#define XB_SPIN_CAP (1u << 18)
__device__ __forceinline__ unsigned xb_ld(unsigned* p)              { return __hip_atomic_load(p, __ATOMIC_RELAXED, __HIP_MEMORY_SCOPE_AGENT); }
__device__ __forceinline__ unsigned xb_add(unsigned* p, unsigned v) { return __hip_atomic_fetch_add(p, v, __ATOMIC_RELAXED, __HIP_MEMORY_SCOPE_AGENT); }
__device__ __forceinline__ unsigned xb_xcc_id() { return (unsigned)__builtin_amdgcn_s_getreg((3 << 11) | 20) & 0xFu; }
#define XB_SPIN(cond, bar) do { unsigned _sp = 0; while (cond) { __builtin_amdgcn_s_sleep(1); \
    if ((++_sp & 255u) == 0u) { if (xb_ld(&(bar)[XB_TMO])) break; if (_sp > XB_SPIN_CAP) { atomicAdd(&(bar)[XB_TMO], 1u); break; } } } } while (0)
struct XcdBarrier { unsigned* bar; unsigned x; volatile LAS unsigned* st; };
__device__ __forceinline__ XcdBarrier xcd_barrier_post(unsigned* bar, volatile LAS unsigned* st) {
    XcdBarrier b; b.bar = bar; b.x = xb_xcc_id(); b.st = st;
    if (threadIdx.x == 0) (void)xb_add(&bar[XB_XCNT(b.x)], 1u);
    return b;
}
__device__ __forceinline__ void xcd_barrier_complete(unsigned* bar, unsigned x, unsigned& nloc, unsigned& nx) {
    const unsigned G = gridDim.x * gridDim.y * gridDim.z;
    unsigned sum, cnt, mine, sp = 0u;
    for (;;) {
        sum = 0u; cnt = 0u; mine = 0u;
#pragma unroll
        for (unsigned j = 0; j < 16; ++j) { const unsigned c = xb_ld(&bar[XB_XCNT(j)]); sum += c; cnt += (c > 0u) ? 1u : 0u; mine = (j == x) ? c : mine; }
        if (sum == G) break;
        __builtin_amdgcn_s_sleep(1);
        if ((++sp & 255u) == 0u) { if (xb_ld(&bar[XB_TMO])) break; if (sp > XB_SPIN_CAP) { atomicAdd(&bar[XB_TMO], 1u); break; } }
    }
    nloc = mine > 0u ? mine : 1u; nx = cnt > 0u ? cnt : 1u;
}
__device__ __forceinline__ void xcd_barrier(const XcdBarrier& b) {
    asm volatile("s_waitcnt vmcnt(0)" ::: "memory");
    __syncthreads();
    if (threadIdx.x == 0) {
        unsigned* bar = b.bar;
        __builtin_amdgcn_s_waitcnt(0);
        unsigned nloc = b.st[0], nx = b.st[1];
        if (nloc == 0u) { xcd_barrier_complete(bar, b.x, nloc, nx); b.st[0] = nloc; b.st[1] = nx; }
        const unsigned old = xb_add(&bar[XB_XSUB(b.x)], 1u);
        const unsigned gen = old / nloc;
        if (old + 1u == (gen + 1u) * nloc) {
            __builtin_amdgcn_fence(__ATOMIC_RELEASE, "agent");
            asm volatile("s_waitcnt vmcnt(0)" ::: "memory");
            const unsigned og = xb_add(&bar[XB_TOP], 1u);
            const unsigned tg = og / nx;
            if (og + 1u == (tg + 1u) * nx) xb_add(&bar[XB_TOPGEN], 1u);
            else XB_SPIN(xb_ld(&bar[XB_TOPGEN]) == tg, bar);
            __builtin_amdgcn_fence(__ATOMIC_ACQUIRE, "agent");
            xb_add(&bar[XB_XGEN(b.x)], 1u);
            asm volatile("s_waitcnt vmcnt(0)" ::: "memory");
        } else {
            XB_SPIN(xb_ld(&bar[XB_XGEN(b.x)]) == gen, bar);
            __builtin_amdgcn_fence(__ATOMIC_ACQUIRE, "agent");
            asm volatile("s_waitcnt vmcnt(0)" ::: "memory");
        }
    }
    __syncthreads();
}

constexpr int N_IN = 27;
enum { I_X = 0, I_C, I_WADA, I_BADA, I_WIN, I_GWA, I_GBA, I_GNG, I_RMU, I_RW0, I_RWUP, I_RA0, I_RAUP, I_RGUP, I_RKK, I_RKA, I_RRK, I_RGNG, I_RGNB, I_WBR, I_WOUT, I_LN1G, I_LN1B, I_W1, I_W2, I_LN2G, I_LN2B };
struct Args { const float* in[N_IN]; float* out; unsigned char* ws; int ph_lo, ph_hi; };
static_assert(sizeof(Args) == N_IN * 8 + 8 + 8 + 8, "Args has no padding");

constexpr int NWAVES = 8, NTHR = 512;
constexpr int RING_BYTES = 131072, MISC_OFF = RING_BYTES + 320, LDS_BYTES = 147456;

struct Frame {
    LAS unsigned char* lds; int tid, lane, wave, bid, G;
    const float* const* in; float* out; unsigned char* ws;
};

__device__ __forceinline__ void phase_mod(const Frame& F) {
    LAS float* sc = (LAS float*)F.lds;
    LAS float* part = sc + 2048;
    const float* c = F.in[I_C];
    for (int i = F.tid; i < 2048; i += NTHR) { const float v = c[i]; sc[i] = v * sigm(v); }
    __syncthreads();
    float* mod = (float*)(F.ws + WS_MOD);
    for (int item = F.bid; item < DEPTH * 96; item += F.G) {
        const int l = item / 96, cg = item % 96, col = cg * 64 + F.lane;
        const float* W = F.in[I_WADA] + (size_t)l * 1024 * 6144 + col;
        float s0 = 0.f, s1 = 0.f; const int k0 = F.wave * 128;
#pragma unroll 8
        for (int kk = 0; kk < 128; ++kk) { const int k = k0 + kk; const float w = W[(size_t)k * 6144]; s0 += sc[k] * w; s1 += sc[1024 + k] * w; }
        part[(F.wave * 2 + 0) * 64 + F.lane] = s0; part[(F.wave * 2 + 1) * 64 + F.lane] = s1;
        __syncthreads();
        if (F.wave < 2) { float t = 0.f;
#pragma unroll
            for (int w = 0; w < 8; ++w) t += part[(w * 2 + F.wave) * 64 + F.lane];
            mod[(size_t)(l * 2 + F.wave) * 6144 + col] = t + F.in[I_BADA][l * 6144 + col]; }
        __syncthreads();
    }
}
__device__ __forceinline__ int map_col(int mode, int n) {
    if (mode == 1) {
        if (n < 1536) return 3344 + n;
        if (n < 2560) return n - 1536;
        if (n < 3072) return 1040 + (n - 2560);
        if (n < 4864) return 1552 + (n - 3072);
        if (n < 4880) return 1024 + (n - 4864);
        if (n < 5120) return -1;
        return 4880 + (n - 5120);
    }
    if (mode == 2) { const int j = n >> 8, w = n & 255; return (w < 128) ? (j * 128 + w) : (FFH + j * 128 + (w - 128)); }
    return n;
}
__device__ __forceinline__ void transpose_item(const float* W, int K, int Nsrc, bf16* WT, int mode, int nblk, LAS float* scr, int item, int lane) {
    const int kb = item / nblk, nb = item % nblk, k0 = 64 * kb, n0 = 32 * nb;
    const int oc = map_col(mode, n0 + (lane & 31));
#pragma unroll 8
    for (int i = 0; i < 32; ++i) { const int kk = 2 * i + (lane >> 5); scr[kk * 33 + (lane & 31)] = (oc >= 0) ? W[(size_t)(k0 + kk) * Nsrc + oc] : 0.f; }
    LDS_WAIT(); asm volatile("" ::: "memory");
    const int c = lane & 7;
#pragma unroll
    for (int j = 0; j < 4; ++j) { const int n = (lane >> 3) + 8 * j; const LAS float* s = scr + (8 * c) * 33 + n;
        v4u o; o.x = pk2(s[0 * 33], s[1 * 33]); o.y = pk2(s[2 * 33], s[3 * 33]); o.z = pk2(s[4 * 33], s[5 * 33]); o.w = pk2(s[6 * 33], s[7 * 33]);
        *(v4u*)(WT + (size_t)(n0 + n) * K + k0 + 8 * c) = o; }
    LDS_WAIT(); asm volatile("" ::: "memory");
}
__device__ __forceinline__ void convert_weights(const Frame& F, int l) {
    LAS float* scr = (LAS float*)(F.lds + F.wave * 16384);
    const int gw = F.bid * NWAVES + F.wave, NGW = F.G * NWAVES;
    constexpr int I_IN = 16 * 256, I_BR = 8 * 32, I_OUT = 16 * 32, I_1 = 16 * 176, I_2 = 44 * 32;
    constexpr int NITEMS = I_IN + 3 * I_BR + I_OUT + I_1 + I_2;
    for (int it = gw; it < NITEMS; it += NGW) {
        int r = it;
        if (r < I_IN) { transpose_item(F.in[I_WIN] + (size_t)l * 1024 * 7952, 1024, 7952, (bf16*)(F.ws + WS_WIN), 1, 256, scr, r, F.lane); continue; } r -= I_IN;
        if (r < 3 * I_BR) { const int n = r / I_BR; transpose_item(F.in[I_WBR] + (size_t)(l * 3 + n) * 512 * 1024, 512, 1024, (bf16*)(F.ws + WS_WBR) + (size_t)n * 1024 * 512, 0, 32, scr, r % I_BR, F.lane); continue; } r -= 3 * I_BR;
        if (r < I_OUT) { transpose_item(F.in[I_WOUT] + (size_t)l * 1024 * 1024, 1024, 1024, (bf16*)(F.ws + WS_WOUT), 0, 32, scr, r, F.lane); continue; } r -= I_OUT;
        if (r < I_1) { transpose_item(F.in[I_W1] + (size_t)l * 1024 * 5632, 1024, 5632, (bf16*)(F.ws + WS_W1), 2, 176, scr, r, F.lane); continue; } r -= I_1;
        transpose_item(F.in[I_W2] + (size_t)l * 2816 * 1024, 2816, 1024, (bf16*)(F.ws + WS_W2), 0, 32, scr, r, F.lane);
    }
}
__device__ __forceinline__ void make_u0(const Frame& F) {
    const int gw = F.bid * NWAVES + F.wave, NGW = F.G * NWAVES;
    const float* mod = (const float*)(F.ws + WS_MOD);
    bf16* ub = (bf16*)(F.ws + WS_UB);
    for (int m = gw; m < M; m += NGW) {
        const int b = m / SEQ; const float* sh = mod + (size_t)(0 * 2 + b) * 6144; const float* scp = sh + 1024;
        const f32x4* xr = (const f32x4*)(F.in[I_X] + (size_t)m * D) + F.lane;
        unsigned long long* o8 = (unsigned long long*)(ub + (size_t)m * D) + F.lane;
#pragma unroll
        for (int j = 0; j < 4; ++j) { const f32x4 v = xr[64 * j]; const f32x4 s = *((const f32x4*)scp + F.lane + 64 * j), h = *((const f32x4*)sh + F.lane + 64 * j);
            const f32x4 u = v * (1.0f + s) + h;
            o8[64 * j] = (unsigned long long)pk2(u[0], u[1]) | ((unsigned long long)pk2(u[2], u[3]) << 32); }
    }
}
__device__ __forceinline__ void phase_ln(const Frame& F, const float* xold, const float* h, const float* gmod  , const float* lg, const float* lb,
                                         float* xout, const float* shmod  , bf16* ub) {
    const int gw = F.bid * NWAVES + F.wave, NGW = F.G * NWAVES;
    for (int m = gw; m < M; m += NGW) {
        const int b = m / SEQ;
        const f32x4* xr = (const f32x4*)(xold + (size_t)m * D) + F.lane; const f32x4* hr = (const f32x4*)(h + (size_t)m * D) + F.lane;
        const f32x4* gr = (const f32x4*)(gmod + (size_t)b * 6144) + F.lane;
        f32x4 v[4]; float s = 0.f;
#pragma unroll
        for (int j = 0; j < 4; ++j) { v[j] = DN_ALPHA * xr[64 * j] + (1.0f + gr[64 * j]) * hr[64 * j]; s += (v[j][0] + v[j][1]) + (v[j][2] + v[j][3]); }
        const float mean = wave_sum(s) * (1.f / D); float s2 = 0.f;
#pragma unroll
        for (int j = 0; j < 4; ++j) { v[j] = v[j] - mean; s2 += (v[j][0] * v[j][0] + v[j][1] * v[j][1]) + (v[j][2] * v[j][2] + v[j][3] * v[j][3]); }
        const float rstd = 1.f / sqrtf(wave_sum(s2) * (1.f / D) + LN_EPS);
        f32x4* xo = (f32x4*)(xout + (size_t)m * D) + F.lane;
        unsigned long long* o8 = (unsigned long long*)(ub + (size_t)m * D) + F.lane;
#pragma unroll
        for (int j = 0; j < 4; ++j) { const f32x4 y = v[j] * rstd * *((const f32x4*)lg + F.lane + 64 * j) + *((const f32x4*)lb + F.lane + 64 * j);
            xo[64 * j] = y;
            if (shmod) { const f32x4 sh = *((const f32x4*)(shmod + (size_t)b * 6144) + F.lane + 64 * j), sc = *((const f32x4*)(shmod + (size_t)b * 6144 + 1024) + F.lane + 64 * j);
                const f32x4 u = y * (1.0f + sc) + sh; o8[64 * j] = (unsigned long long)pk2(u[0], u[1]) | ((unsigned long long)pk2(u[2], u[3]) << 32); } }
    }
}
__device__ __forceinline__ void phase_rwprep(const Frame& F, int l) {
    LAS float* inl = (LAS float*)F.lds;
    const bf16* P = (const bf16*)(F.ws + WS_P);
    bf16* rw_lw = (bf16*)(F.ws + WS_RW); bf16* rw_a = rw_lw + (size_t)M * 512; bf16* rw_g = rw_a + (size_t)M * 512;
    const float* mu = F.in[I_RMU] + l * 1792 + 1536;
    const float* w_up = F.in[I_RWUP] + (size_t)l * 64 * 512; const float* a_up = F.in[I_RAUP] + (size_t)l * 64 * 512; const float* g_up = F.in[I_RGUP] + (size_t)l * 128 * 512;
    const int c = F.tid;
    const float w0 = F.in[I_RW0][l * 512 + c], a0 = F.in[I_RA0][l * 512 + c];
    for (int item = F.bid; item < M / 16; item += F.G) {
        const int m0 = item * 16;
#pragma unroll
        for (int i = 0; i < 8; ++i) { const int idx = i * NTHR + F.tid, t = idx >> 8, j = idx & 255, m = m0 + t;
            const float cur = bf2f(P[(size_t)m * NP + C_RLO + j]); const float prev = (m % SEQ == 0) ? 0.f : bf2f(P[(size_t)(m - 1) * NP + C_RLO + j]);
            const float xs = cur + (prev - cur) * mu[j];
            inl[j * 16 + t] = (j < 64) ? tanhf(xs) : ((j < 128) ? xs : sigm(xs)); }
        __syncthreads();
        float aw[16], aa[16], ag[16];
#pragma unroll
        for (int t = 0; t < 16; ++t) { aw[t] = 0.f; aa[t] = 0.f; ag[t] = 0.f; }
#pragma unroll 4
        for (int j = 0; j < 64; ++j) { const float w = w_up[j * 512 + c]; const LAS f32x4* p = (const LAS f32x4*)(inl + j * 16);
#pragma unroll
            for (int q = 0; q < 4; ++q) { const f32x4 x = p[q]; aw[q * 4 + 0] += x[0] * w; aw[q * 4 + 1] += x[1] * w; aw[q * 4 + 2] += x[2] * w; aw[q * 4 + 3] += x[3] * w; } }
#pragma unroll 4
        for (int j = 0; j < 64; ++j) { const float w = a_up[j * 512 + c]; const LAS f32x4* p = (const LAS f32x4*)(inl + (64 + j) * 16);
#pragma unroll
            for (int q = 0; q < 4; ++q) { const f32x4 x = p[q]; aa[q * 4 + 0] += x[0] * w; aa[q * 4 + 1] += x[1] * w; aa[q * 4 + 2] += x[2] * w; aa[q * 4 + 3] += x[3] * w; } }
#pragma unroll 4
        for (int j = 0; j < 128; ++j) { const float w = g_up[j * 512 + c]; const LAS f32x4* p = (const LAS f32x4*)(inl + (128 + j) * 16);
#pragma unroll
            for (int q = 0; q < 4; ++q) { const f32x4 x = p[q]; ag[q * 4 + 0] += x[0] * w; ag[q * 4 + 1] += x[1] * w; ag[q * 4 + 2] += x[2] * w; ag[q * 4 + 3] += x[3] * w; } }
#pragma unroll
        for (int t = 0; t < 16; ++t) { const size_t o = (size_t)(m0 + t) * 512 + c;
            const float wl = -softplusf_(-(w0 + aw[t])) - 0.5f;
            rw_lw[o] = (bf16)f2bf(-__expf(wl)); rw_a[o] = (bf16)f2bf(sigm(a0 + aa[t])); rw_g[o] = (bf16)f2bf(ag[t]); }
        __syncthreads();
    }
}
__device__ __forceinline__ void rwkv_scan_wave(const Frame& F, int l, int bh) {
    const int b = bh >> 3, h = bh & 7, lane = F.lane, c = h * 64 + lane;
    LAS float* L = (LAS float*)F.lds;
    LAS float* Lkk = L, *Lw = L + 1024, *Lb = L + 2048, *Lk = L + 3072, *Lr = L + 4096, *Lv = L + 5120, *Ly = L + 6144, *Lrk = L + 7168;
    const bf16* P = (const bf16*)(F.ws + WS_P);
    const bf16* rw_lw = (const bf16*)(F.ws + WS_RW); const bf16* rw_a = rw_lw + (size_t)M * 512; const bf16* rw_g = rw_a + (size_t)M * 512;
    bf16* outB = (bf16*)(F.ws + WS_BR) + (size_t)M * 512;
    const float* mu = F.in[I_RMU] + l * 1792;
    const float mu_r = mu[c], mu_k = mu[512 + c], mu_v = mu[1024 + c];
    const float k_k = F.in[I_RKK][l * 512 + c], k_a = F.in[I_RKA][l * 512 + c], r_k = F.in[I_RRK][l * 512 + c], gn_g = F.in[I_RGNG][l * 512 + c], gn_b = F.in[I_RGNB][l * 512 + c];
    float S[64];
#pragma unroll
    for (int k = 0; k < 64; ++k) S[k] = 0.f;
    float pr = 0.f, pk = 0.f, pv = 0.f;
    for (int t0 = 0; t0 < SEQ; t0 += 16) {
        float cr[16], ck[16], cv[16], lw[16], av[16];
#pragma unroll
        for (int t = 0; t < 16; ++t) { const size_t m = (size_t)b * SEQ + t0 + t; const bf16* pp = P + m * NP;
            cr[t] = bf2f(pp[C_RR + c]); ck[t] = bf2f(pp[C_RK + c]); cv[t] = bf2f(pp[C_RV + c]); lw[t] = bf2f(rw_lw[m * 512 + c]); av[t] = bf2f(rw_a[m * 512 + c]); }
#pragma unroll
        for (int t = 0; t < 16; ++t) {
            const float r = cr[t] + (pr - cr[t]) * mu_r, k = ck[t] + (pk - ck[t]) * mu_k, v = cv[t] + (pv - cv[t]) * mu_v;
            pr = cr[t]; pk = ck[t]; pv = cv[t];
            const float a = av[t];
            const float kkv = k * k_k; const float n2 = wave_sum(kkv * kkv); const float kk = kkv / fmaxf(sqrtf(n2), 1e-12f);
            const float kp = k * (1.0f + (a - 1.0f) * k_a);
            const float rk = wave_sum(r * kp * r_k);
            Lkk[t * 64 + lane] = kk; Lw[t * 64 + lane] = __expf(lw[t]); Lb[t * 64 + lane] = kk * a; Lk[t * 64 + lane] = kp; Lr[t * 64 + lane] = r; Lv[t * 64 + lane] = v;
            if (lane == 0) Lrk[t] = rk;
        }
        LDS_WAIT(); asm volatile("" ::: "memory");
#pragma unroll 1
        for (int t = 0; t < 16; ++t) {
            const LAS f32x4* q_kk = (const LAS f32x4*)(Lkk + t * 64); const LAS f32x4* q_w = (const LAS f32x4*)(Lw + t * 64); const LAS f32x4* q_b = (const LAS f32x4*)(Lb + t * 64);
            const LAS f32x4* q_k = (const LAS f32x4*)(Lk + t * 64); const LAS f32x4* q_r = (const LAS f32x4*)(Lr + t * 64);
            const float vt = Lv[t * 64 + lane];
            float sa = 0.f;
#pragma unroll
            for (int k4 = 0; k4 < 16; ++k4) { const f32x4 x = q_kk[k4]; sa -= S[4 * k4] * x[0]; sa -= S[4 * k4 + 1] * x[1]; sa -= S[4 * k4 + 2] * x[2]; sa -= S[4 * k4 + 3] * x[3]; }
            float y = 0.f;
#pragma unroll
            for (int k4 = 0; k4 < 16; ++k4) { const f32x4 w = q_w[k4], bb = q_b[k4], kx = q_k[k4], rr = q_r[k4];
#pragma unroll
                for (int i = 0; i < 4; ++i) { const float s = S[4 * k4 + i] * w[i] + sa * bb[i] + vt * kx[i]; S[4 * k4 + i] = s; y += s * rr[i]; } }
            Ly[t * 64 + lane] = y;
        }
        LDS_WAIT(); asm volatile("" ::: "memory");
#pragma unroll 4
        for (int t = 0; t < 16; ++t) { const size_t m = (size_t)b * SEQ + t0 + t;
            const float y = Ly[t * 64 + lane]; const float mean = wave_sum(y) * (1.f / 64.f); const float d = y - mean; const float var = wave_sum(d * d) * (1.f / 64.f);
            const float yn = d * (1.0f / sqrtf(var + GN_EPS)) * gn_g + gn_b;
            const float o = (yn + Lrk[t] * Lv[t * 64 + lane]) * bf2f(rw_g[m * 512 + c]);
            outB[m * 512 + c] = (bf16)f2bf(o); }
        LDS_WAIT(); asm volatile("" ::: "memory");
    }
}
__device__ __forceinline__ void gla_scan_wave(const Frame& F, int l, int idx) {
    const int half = idx & 1, bh = idx >> 1, b = bh >> 2, h = bh & 3, lane = F.lane, ck = h * 64 + lane, vcol = h * 128 + half * 64 + lane;
    LAS float* L = (LAS float*)F.lds;
    LAS float* La = L, *Lk = L + 1024, *Lq = L + 2048, *Lv = L + 3072, *Lga = L + 4096;
    const bf16* P = (const bf16*)(F.ws + WS_P);
    float* GO = (float*)(F.ws + WS_GO);
    const float* wa = F.in[I_GWA] + (size_t)l * 16 * 256; const float ba = F.in[I_GBA][l * 256 + ck];
    float war[16];
#pragma unroll
    for (int j = 0; j < 16; ++j) war[j] = wa[j * 256 + ck];
    float S[64];
#pragma unroll
    for (int k = 0; k < 64; ++k) S[k] = 0.f;
    for (int t0 = 0; t0 < SEQ; t0 += 16) {
        const size_t m0 = (size_t)b * SEQ + t0;
        { const int t = lane >> 2, q = lane & 3; const uint2 gw = *(const uint2*)(P + (m0 + t) * NP + C_GA + 4 * q);
          LAS float* d = Lga + t * 16 + 4 * q; d[0] = __uint_as_float(gw.x << 16); d[1] = __uint_as_float(gw.x & 0xffff0000u); d[2] = __uint_as_float(gw.y << 16); d[3] = __uint_as_float(gw.y & 0xffff0000u); }
        float kx[16], qx[16], vx[16];
#pragma unroll
        for (int t = 0; t < 16; ++t) { const bf16* pp = P + (m0 + t) * NP; kx[t] = bf2f(pp[C_GK + ck]); qx[t] = bf2f(pp[C_GQ + ck]) * 0.125f; vx[t] = bf2f(pp[C_GV + vcol]); }
        LDS_WAIT(); asm volatile("" ::: "memory");
#pragma unroll
        for (int t = 0; t < 16; ++t) {
            float z = ba; const LAS f32x4* g4 = (const LAS f32x4*)(Lga + t * 16);
#pragma unroll
            for (int j4 = 0; j4 < 4; ++j4) { const f32x4 g = g4[j4]; z += g[0] * war[4 * j4] + g[1] * war[4 * j4 + 1] + g[2] * war[4 * j4 + 2] + g[3] * war[4 * j4 + 3]; }
            const float ls = fminf(z, 0.f) - log1pf(__expf(-fabsf(z)));
            La[t * 64 + lane] = __expf(ls * (1.0f / 16.0f)); Lk[t * 64 + lane] = kx[t]; Lq[t * 64 + lane] = qx[t]; Lv[t * 64 + lane] = vx[t]; }
        LDS_WAIT(); asm volatile("" ::: "memory");
#pragma unroll 1
        for (int t = 0; t < 16; ++t) {
            const LAS f32x4* q_a = (const LAS f32x4*)(La + t * 64); const LAS f32x4* q_k = (const LAS f32x4*)(Lk + t * 64); const LAS f32x4* q_q = (const LAS f32x4*)(Lq + t * 64);
            const float vt = Lv[t * 64 + lane]; float o = 0.f;
#pragma unroll
            for (int k4 = 0; k4 < 16; ++k4) { const f32x4 a = q_a[k4], kk = q_k[k4], qq = q_q[k4];
#pragma unroll
                for (int i = 0; i < 4; ++i) { const float s = a[i] * S[4 * k4 + i] + kk[i] * vt; S[4 * k4 + i] = s; o += qq[i] * s; } }
            GO[(m0 + t) * 512 + vcol] = o;
        }
        LDS_WAIT(); asm volatile("" ::: "memory");
    }
}
__device__ __forceinline__ void attn_waves(const Frame& F, int wave_id, int nwaves) {
    LAS float* L = (LAS float*)(F.lds + 65536) + F.wave * 512;
    LAS float* Lq = L, *Lp = L + 64;
    const bf16* P = (const bf16*)(F.ws + WS_P);
    bf16* outC = (bf16*)(F.ws + WS_BR) + (size_t)2 * M * 512;
    const int lane = F.lane;
    for (int qi = wave_id; qi < BATCH * 8 * SEQ; qi += nwaves) {
        const int t = qi % SEQ, bh = qi / SEQ, h = bh & 7, b = bh >> 3;
        const size_t m = (size_t)b * SEQ + t;
        const float slope = exp2f(-(float)(h + 1));
        Lq[lane] = bf2f(P[m * NP + C_ATQ + h * 64 + lane]);
        LDS_WAIT(); asm volatile("" ::: "memory");
        float sc[7]; float mx = -INFINITY;
#pragma unroll
        for (int r = 0; r < 7; ++r) { const int e = r * 64 + lane; const int pi = e / 129, j = e - pi * 129; const int d = (pi == 0) ? 1 : ((pi == 1) ? 4 : 16); const int pos = t - j * d;
            float s = -INFINITY;
            if (e < 387 && pos >= 0) { const v4u* kr = (const v4u*)(P + ((size_t)b * SEQ + pos) * NP + C_ATK + h * 64); float dot = 0.f;
#pragma unroll
                for (int i = 0; i < 8; ++i) { const v4u kw = kr[i]; const LAS f32x4* q4 = (const LAS f32x4*)(Lq + i * 8); const f32x4 qa = q4[0], qb = q4[1];
                    dot += qa[0] * __uint_as_float(kw.x << 16) + qa[1] * __uint_as_float(kw.x & 0xffff0000u) + qa[2] * __uint_as_float(kw.y << 16) + qa[3] * __uint_as_float(kw.y & 0xffff0000u)
                         + qb[0] * __uint_as_float(kw.z << 16) + qb[1] * __uint_as_float(kw.z & 0xffff0000u) + qb[2] * __uint_as_float(kw.w << 16) + qb[3] * __uint_as_float(kw.w & 0xffff0000u); }
                s = dot * 0.125f - slope * (float)(j * d); }
            sc[r] = s; mx = fmaxf(mx, s); }
        mx = wave_max(mx);
        float den = 0.f;
#pragma unroll
        for (int r = 0; r < 7; ++r) { const float p = (sc[r] == -INFINITY) ? 0.f : __expf(sc[r] - mx); den += p; Lp[r * 64 + lane] = p; }
        den = wave_sum(den);
        LDS_WAIT(); asm volatile("" ::: "memory");
        float acc = 0.f;
#pragma unroll
        for (int pi = 0; pi < 3; ++pi) { const int d = (pi == 0) ? 1 : ((pi == 1) ? 4 : 16); const int jmax = min(128, t / d);
            const bf16* vb = P + ((size_t)b * SEQ + t) * NP + C_ATV + h * 64 + lane;
#pragma unroll 4
            for (int j = 0; j <= jmax; ++j) { const float p = Lp[pi * 129 + j]; acc += p * bf2f(vb[-(ptrdiff_t)j * d * NP]); } }
        outC[m * 512 + h * 64 + lane] = (bf16)f2bf(acc / den);
        LDS_WAIT(); asm volatile("" ::: "memory");
    }
}
__device__ __forceinline__ void phase_gla_post(const Frame& F, int l) {
    const int gw = F.bid * NWAVES + F.wave, NGW = F.G * NWAVES;
    const float* GO = (const float*)(F.ws + WS_GO); const bf16* P = (const bf16*)(F.ws + WS_P);
    bf16* outA = (bf16*)(F.ws + WS_BR);
    const float ng0 = F.in[I_GNG][l * 128 + 2 * F.lane], ng1 = F.in[I_GNG][l * 128 + 2 * F.lane + 1];
    for (int it = gw; it < M * 4; it += NGW) {
        const int m = it >> 2, h = it & 3; const int col = h * 128 + 2 * F.lane;
        const float2 o = *(const float2*)(GO + (size_t)m * 512 + col);
        const float ms = wave_sum(o.x * o.x + o.y * o.y) * (1.f / 128.f); const float rs = 1.0f / sqrtf(ms + GLA_EPS);
        const unsigned gw2 = *(const unsigned*)(P + (size_t)m * NP + C_GG + col);
        const float g0 = __uint_as_float(gw2 << 16), g1 = __uint_as_float(gw2 & 0xffff0000u);
        *(unsigned*)(outA + (size_t)m * 512 + col) = pk2(o.x * rs * ng0 * g0 * sigm(g0), o.y * rs * ng1 * g1 * sigm(g1));
    }
}


typedef short bf16x8 __attribute__((ext_vector_type(8)));
typedef float f32x16 __attribute__((ext_vector_type(16)));
typedef unsigned v2u __attribute__((ext_vector_type(2)));
constexpr int CH = 64, NCH = SEQ / CH;
__device__ __forceinline__ unsigned cvtpk(float lo, float hi) { unsigned r; asm volatile("v_cvt_pk_bf16_f32 %0, %1, %2" : "=v"(r) : "v"(lo), "v"(hi)); return r; }

__device__ __forceinline__ void attn_unit(const Frame& F, int pi, int unit, LAS bf16* Vt) {
    const int dl = (pi == 0) ? 1 : ((pi == 1) ? 4 : 16), lg = (pi == 0) ? 0 : ((pi == 1) ? 2 : 4);
    const int bh = unit >> 8, rem = unit & 255, b = bh >> 3, h = bh & 7;
    const int per = 256 >> lg, res = rem / per, i0 = (rem % per) * 32;
    const int lane = F.lane, rr = lane & 31, hh = lane >> 5;
    const bf16* Pb = (const bf16*)(F.ws + WS_P) + ((size_t)b * SEQ + res) * NP;
    const size_t rstride = (size_t)dl * NP;
    const float slope = exp2f(-(float)(h + 1)) * (float)dl;
    bf16x8 qf[4];
    { const bf16* qp = Pb + (size_t)(i0 + rr) * rstride + C_ATQ + h * 64 + 8 * hh;
#pragma unroll
      for (int ks = 0; ks < 4; ++ks) qf[ks] = *(const bf16x8*)(qp + 16 * ks); }
    f32x16 o[2];
#pragma unroll
    for (int i = 0; i < 16; ++i) { o[0][i] = 0.f; o[1][i] = 0.f; }
    float mx = -1e30f, den = 0.f;
#pragma unroll 1
    for (int kt = (i0 >= 128 ? 0 : 4 - (i0 >> 5)); kt < 5; ++kt) {
        const int ik = i0 - 128 + 32 * kt + rr;
        const bf16* kp = Pb + (size_t)ik * rstride + C_ATK + h * 64 + 8 * hh;
        bf16x8 kf[4];
#pragma unroll
        for (int ks = 0; ks < 4; ++ks) kf[ks] = *(const bf16x8*)(kp + 16 * ks);
        const bf16* vp = Pb + (size_t)ik * rstride + C_ATV + h * 64;
        v4u vv[4];
#pragma unroll
        for (int i = 0; i < 4; ++i) vv[i] = *(const v4u*)(vp + 8 * (hh + 2 * i));
        f32x16 st;
#pragma unroll
        for (int i = 0; i < 16; ++i) st[i] = 0.f;
#pragma unroll
        for (int ks = 0; ks < 4; ++ks) st = __builtin_amdgcn_mfma_f32_32x32x16_bf16(kf[ks], qf[ks], st, 0, 0, 0);
        float tmx = -1e30f;
#pragma unroll
        for (int i = 0; i < 16; ++i) { const int keyrow = (i & 3) + 8 * (i >> 2) + 4 * hh; const int dist = rr + 128 - 32 * kt - keyrow;
            const bool valid = (dist >= 0) && (dist <= 128);
            const float sv = valid ? (st[i] * 0.125f - slope * (float)dist) : -1e30f; st[i] = sv; tmx = fmaxf(tmx, sv); }
        tmx = fmaxf(tmx, __shfl_xor(tmx, 32));
        const float mnew = fmaxf(mx, tmx); const float alpha = __expf(mx - mnew); mx = mnew;
        float ts = 0.f;
#pragma unroll
        for (int i = 0; i < 16; ++i) { const float p = (st[i] > -1e29f) ? __expf(st[i] - mnew) : 0.f; st[i] = p; ts += p; }
        ts += __shfl_xor(ts, 32);
        den = den * alpha + ts;
#pragma unroll
        for (int i = 0; i < 16; ++i) { o[0][i] *= alpha; o[1][i] *= alpha; }
#pragma unroll
        for (int i = 0; i < 4; ++i) { const int dg = hh + 2 * i; const v4u v = vv[i];
            LAS bf16* d = Vt + (8 * dg) * 36 + rr;
            d[0 * 36] = (bf16)(v.x & 0xffffu); d[1 * 36] = (bf16)(v.x >> 16); d[2 * 36] = (bf16)(v.y & 0xffffu); d[3 * 36] = (bf16)(v.y >> 16);
            d[4 * 36] = (bf16)(v.z & 0xffffu); d[5 * 36] = (bf16)(v.z >> 16); d[6 * 36] = (bf16)(v.w & 0xffffu); d[7 * 36] = (bf16)(v.w >> 16); }
        LDS_WAIT(); asm volatile("" ::: "memory");
#pragma unroll
        for (int sI = 0; sI < 2; ++sI) {
            union { unsigned u[4]; bf16x8 v; } pb;
#pragma unroll
            for (int j = 0; j < 4; ++j) pb.u[j] = cvtpk(st[8 * sI + 2 * j], st[8 * sI + 2 * j + 1]);
#pragma unroll
            for (int dt = 0; dt < 2; ++dt) { const LAS bf16* a = Vt + (rr + 32 * dt) * 36 + 16 * sI + 4 * hh;
                union { v2u q[2]; bf16x8 v; } af; af.q[0] = *(const LAS v2u*)a; af.q[1] = *(const LAS v2u*)(a + 8);
                o[dt] = __builtin_amdgcn_mfma_f32_32x32x16_bf16(af.v, pb.v, o[dt], 0, 0, 0); }
        }
        LDS_WAIT(); asm volatile("" ::: "memory");
    }
    const size_t mq = (size_t)b * SEQ + res + (size_t)dl * (i0 + rr);
    float* lsep = (float*)(F.ws + WS_LSE) + mq * 8 + h;
    bf16* op = (bf16*)(F.ws + WS_BR) + (size_t)2 * M * 512 + mq * 512 + h * 64 + 4 * hh;
    const float lse = mx + __logf(den); float wn = 1.0f / den, wo = 0.f;
    if (pi > 0) { const float lo_ = *lsep; const float ln = fmaxf(lo_, lse) + __logf(1.0f + __expf(-fabsf(lo_ - lse))); wo = __expf(lo_ - ln); wn = __expf(lse - ln) / den; if (hh == 0) *lsep = ln; }
    else if (hh == 0) *lsep = lse;
#pragma unroll
    for (int dt = 0; dt < 2; ++dt)
#pragma unroll
        for (int g = 0; g < 4; ++g) { bf16* p = op + 32 * dt + 8 * g; float v0 = o[dt][4 * g] * wn, v1 = o[dt][4 * g + 1] * wn, v2 = o[dt][4 * g + 2] * wn, v3 = o[dt][4 * g + 3] * wn;
            if (pi > 0) { const v2u ow = *(const v2u*)p; v0 += wo * __uint_as_float(ow.x << 16); v1 += wo * __uint_as_float(ow.x & 0xffff0000u); v2 += wo * __uint_as_float(ow.y << 16); v3 += wo * __uint_as_float(ow.y & 0xffff0000u); }
            v2u w; w.x = cvtpk(v0, v1); w.y = cvtpk(v2, v3); *(v2u*)p = w; }
}

template <int MODE>
__device__ __forceinline__ void gla_chunk(const Frame& F, int l, int unit, LAS float* Lw) {
    const int bh = unit >> 7, ch = unit & 127, b = bh >> 2, h = bh & 3, lane = F.lane, ck = h * 64 + lane;
    LAS float* La = Lw, *Lk = Lw + 512, *Lq = Lw + 1024, *Lv0 = Lw + 1536, *Lv1 = Lw + 2048, *Lg0 = Lw + 2560, *Lg1 = Lw + 3072, *Lga = Lw + 3584;
    const bf16* P = (const bf16*)(F.ws + WS_P);
    float* DS = (float*)(F.ws + WS_DS) + (size_t)unit * 64 * 128;
    const float* wa = F.in[I_GWA] + (size_t)l * 16 * 256; const float ba = F.in[I_GBA][l * 256 + ck];
    float war[16];
#pragma unroll
    for (int j = 0; j < 16; ++j) war[j] = wa[j * 256 + ck];
    float S0[64], S1[64];
    if (MODE == 1) {
#pragma unroll
        for (int k = 0; k < 64; ++k) { S0[k] = 0.f; S1[k] = 0.f; }
    } else {
#pragma unroll
        for (int k = 0; k < 64; ++k) { S0[k] = DS[k * 128 + lane]; S1[k] = DS[k * 128 + 64 + lane]; }
    }
    float ng0 = 0.f, ng1 = 0.f;
    if (MODE == 3) { ng0 = F.in[I_GNG][l * 128 + lane]; ng1 = F.in[I_GNG][l * 128 + 64 + lane]; }
    float lsum = 0.f;
    const size_t mc = (size_t)b * SEQ + ch * CH;
#pragma unroll 1
    for (int g = 0; g < 8; ++g) {
        const size_t m0 = mc + 8 * g;
        if (lane < 32) { const int t = lane >> 2, q = lane & 3; const v2u gw = *(const v2u*)(P + (m0 + t) * NP + C_GA + 4 * q);
            LAS float* d = Lga + t * 16 + 4 * q; d[0] = __uint_as_float(gw.x << 16); d[1] = __uint_as_float(gw.x & 0xffff0000u); d[2] = __uint_as_float(gw.y << 16); d[3] = __uint_as_float(gw.y & 0xffff0000u); }
#pragma unroll
        for (int t = 0; t < 8; ++t) { const bf16* pp = P + (m0 + t) * NP; Lk[t * 64 + lane] = bf2f(pp[C_GK + ck]); Lv0[t * 64 + lane] = bf2f(pp[C_GV + h * 128 + lane]); Lv1[t * 64 + lane] = bf2f(pp[C_GV + h * 128 + 64 + lane]);
            if (MODE == 3) { Lq[t * 64 + lane] = bf2f(pp[C_GQ + ck]) * 0.125f; Lg0[t * 64 + lane] = bf2f(pp[C_GG + h * 128 + lane]); Lg1[t * 64 + lane] = bf2f(pp[C_GG + h * 128 + 64 + lane]); } }
        LDS_WAIT(); asm volatile("" ::: "memory");
#pragma unroll
        for (int t = 0; t < 8; ++t) {
            float z = ba; const LAS f32x4* g4 = (const LAS f32x4*)(Lga + t * 16);
#pragma unroll
            for (int j4 = 0; j4 < 4; ++j4) { const f32x4 gq = g4[j4]; z += gq[0] * war[4 * j4] + gq[1] * war[4 * j4 + 1] + gq[2] * war[4 * j4 + 2] + gq[3] * war[4 * j4 + 3]; }
            const float ls = (fminf(z, 0.f) - log1pf(__expf(-fabsf(z)))) * (1.0f / 16.0f);
            lsum += ls; La[t * 64 + lane] = __expf(ls); }
        LDS_WAIT(); asm volatile("" ::: "memory");
#pragma unroll 1
        for (int t = 0; t < 8; ++t) {
            const LAS f32x4* q_a = (const LAS f32x4*)(La + t * 64); const LAS f32x4* q_k = (const LAS f32x4*)(Lk + t * 64); const LAS f32x4* q_q = (const LAS f32x4*)(Lq + t * 64);
            const float vt0 = Lv0[t * 64 + lane], vt1 = Lv1[t * 64 + lane]; float o0 = 0.f, o1 = 0.f;
#pragma unroll
            for (int k4 = 0; k4 < 16; ++k4) { const f32x4 a = q_a[k4], kk = q_k[k4]; f32x4 qq; if (MODE == 3) qq = q_q[k4];
#pragma unroll
                for (int i = 0; i < 4; ++i) { const float s0 = a[i] * S0[4 * k4 + i] + kk[i] * vt0, s1 = a[i] * S1[4 * k4 + i] + kk[i] * vt1; S0[4 * k4 + i] = s0; S1[4 * k4 + i] = s1;
                    if (MODE == 3) { o0 += qq[i] * s0; o1 += qq[i] * s1; } } }
            if (MODE == 3) {
                const float ms = wave_sum(o0 * o0 + o1 * o1) * (1.f / 128.f); const float rs = 1.0f / sqrtf(ms + GLA_EPS);
                const float gx0 = Lg0[t * 64 + lane], gx1 = Lg1[t * 64 + lane];
                bf16* ob = (bf16*)(F.ws + WS_BR) + (m0 + t) * 512 + h * 128;
                ob[lane] = (bf16)f2bf(o0 * rs * ng0 * gx0 * sigm(gx0)); ob[64 + lane] = (bf16)f2bf(o1 * rs * ng1 * gx1 * sigm(gx1));
            }
        }
        LDS_WAIT(); asm volatile("" ::: "memory");
    }
    if (MODE == 1) {
#pragma unroll
        for (int k = 0; k < 64; ++k) { DS[k * 128 + lane] = S0[k]; DS[k * 128 + 64 + lane] = S1[k]; }
        ((float*)(F.ws + WS_GDEC))[unit * 64 + lane] = __expf(lsum);
    }
}
__device__ __forceinline__ void gla_p2(const Frame& F, int gid) {
    const int bh = gid >> 13, kv = gid & 8191, k = kv >> 7;
    float* DS = (float*)(F.ws + WS_DS) + (size_t)bh * NCH * 8192 + kv; const float* dec = (const float*)(F.ws + WS_GDEC) + (size_t)bh * NCH * 64 + k;
    float s = 0.f;
#pragma unroll 1
    for (int c0 = 0; c0 < NCH; c0 += 8) { float d[8], dc[8];
#pragma unroll
        for (int i = 0; i < 8; ++i) { d[i] = DS[(size_t)(c0 + i) * 8192]; dc[i] = dec[(c0 + i) * 64]; }
#pragma unroll
        for (int i = 0; i < 8; ++i) { DS[(size_t)(c0 + i) * 8192] = s; s = dc[i] * s + d[i]; } }
}

template <int MODE>
__device__ __forceinline__ void rwkv_chunk(const Frame& F, int l, int unit, LAS float* Lw) {
    const int bh = unit >> 7, ch = unit & 127, b = bh >> 3, h = bh & 7, lane = F.lane, c = h * 64 + lane;
    LAS float* Lkk = Lw, *Lwd = Lw + 512, *Lb = Lw + 1024, *Lk = Lw + 1536, *Lr = Lw + 2048, *Lv = Lw + 2560, *Lg = Lw + 3072, *Lrk = Lw + 3584;
    const bf16* P = (const bf16*)(F.ws + WS_P);
    const bf16* rw_lw = (const bf16*)(F.ws + WS_RW); const bf16* rw_a = rw_lw + (size_t)M * 512; const bf16* rw_g = rw_a + (size_t)M * 512;
    bf16* outB = (bf16*)(F.ws + WS_BR) + (size_t)M * 512;
    float* QS = (float*)(F.ws + WS_QS) + ((size_t)unit * 64 + lane) * 64; float* PM = (float*)(F.ws + WS_PM) + ((size_t)unit * 64 + lane) * 64;
    const float* mu = F.in[I_RMU] + l * 1792;
    const float mu_r = mu[c], mu_k = mu[512 + c], mu_v = mu[1024 + c];
    const float k_k = F.in[I_RKK][l * 512 + c], k_a = F.in[I_RKA][l * 512 + c];
    float r_k = 0.f, gn_g = 0.f, gn_b = 0.f;
    if (MODE == 3) { r_k = F.in[I_RRK][l * 512 + c]; gn_g = F.in[I_RGNG][l * 512 + c]; gn_b = F.in[I_RGNB][l * 512 + c]; }
    float S[64];
    if (MODE == 1 || MODE == 2) {
        int ln_ = lane; asm volatile("" : "+v"(ln_));
#pragma unroll
        for (int k = 0; k < 64; ++k) S[k] = (MODE == 2 && k == ln_) ? 1.f : 0.f;
    } else {
#pragma unroll
        for (int k4 = 0; k4 < 16; ++k4) { const f32x4 x = *(const f32x4*)(QS + 4 * k4); S[4 * k4] = x[0]; S[4 * k4 + 1] = x[1]; S[4 * k4 + 2] = x[2]; S[4 * k4 + 3] = x[3]; }
    }
    const size_t mc = (size_t)b * SEQ + ch * CH;
    float pr = 0.f, pk = 0.f, pv = 0.f;
    if (ch > 0) { const bf16* pp = P + (mc - 1) * NP; pr = bf2f(pp[C_RR + c]); pk = bf2f(pp[C_RK + c]); pv = bf2f(pp[C_RV + c]); }
#pragma unroll 1
    for (int g = 0; g < 8; ++g) {
        const size_t m0 = mc + 8 * g;
#pragma unroll 1
        for (int tb = 0; tb < 8; tb += 4) {
        float cr[4], ck[4], cv[4], lw[4], av[4];
#pragma unroll
        for (int t = 0; t < 4; ++t) { const size_t m = m0 + tb + t; const bf16* pp = P + m * NP;
            ck[t] = bf2f(pp[C_RK + c]); cv[t] = bf2f(pp[C_RV + c]); lw[t] = bf2f(rw_lw[m * 512 + c]); av[t] = bf2f(rw_a[m * 512 + c]);
            if (MODE == 3) { cr[t] = bf2f(pp[C_RR + c]); Lg[(tb + t) * 64 + lane] = bf2f(rw_g[m * 512 + c]); } }
#pragma unroll
        for (int t = 0; t < 4; ++t) { const int tt = tb + t;
            const float k = ck[t] + (pk - ck[t]) * mu_k, v = cv[t] + (pv - cv[t]) * mu_v; pk = ck[t]; pv = cv[t];
            const float a = av[t];
            const float kkv = k * k_k; const float n2 = wave_sum(kkv * kkv); const float kk = kkv / fmaxf(sqrtf(n2), 1e-12f);
            const float kp = k * (1.0f + (a - 1.0f) * k_a);
            Lkk[tt * 64 + lane] = kk; Lwd[tt * 64 + lane] = __expf(lw[t]); Lb[tt * 64 + lane] = kk * a; Lk[tt * 64 + lane] = kp; Lv[tt * 64 + lane] = v;
            if (MODE == 3) { const float r = cr[t] + (pr - cr[t]) * mu_r; pr = cr[t]; Lr[tt * 64 + lane] = r; const float rk = wave_sum(r * kp * r_k); if (lane == 0) Lrk[tt] = rk; }
        }
        }
        LDS_WAIT(); asm volatile("" ::: "memory");
#pragma unroll 1
        for (int t = 0; t < 8; ++t) {
            const LAS f32x4* q_kk = (const LAS f32x4*)(Lkk + t * 64); const LAS f32x4* q_w = (const LAS f32x4*)(Lwd + t * 64); const LAS f32x4* q_b = (const LAS f32x4*)(Lb + t * 64);
            const LAS f32x4* q_k = (const LAS f32x4*)(Lk + t * 64); const LAS f32x4* q_r = (const LAS f32x4*)(Lr + t * 64);
            const float vt = Lv[t * 64 + lane];
            float sa0 = 0.f, sa1 = 0.f;
#pragma unroll
            for (int k4 = 0; k4 < 16; ++k4) { const f32x4 x = q_kk[k4];
                sa0 -= S[4 * k4] * x[0]; sa1 -= S[4 * k4 + 1] * x[1]; sa0 -= S[4 * k4 + 2] * x[2]; sa1 -= S[4 * k4 + 3] * x[3];
            }
            const float sa = sa0 + sa1;
            float y0 = 0.f, y1 = 0.f;
#pragma unroll
            for (int k4 = 0; k4 < 16; ++k4) { const f32x4 w = q_w[k4], bb = q_b[k4], kx = q_k[k4]; f32x4 rr; if (MODE == 3) rr = q_r[k4];
#pragma unroll
                for (int i = 0; i < 4; ++i) { const float sn = (MODE == 2) ? (S[4 * k4 + i] * w[i] + sa * bb[i]) : (S[4 * k4 + i] * w[i] + sa * bb[i] + vt * kx[i]); S[4 * k4 + i] = sn;
                    if (MODE == 3) { if (i & 1) y1 += sn * rr[i]; else y0 += sn * rr[i]; } } }
            if (MODE == 3) { const size_t m = m0 + t; const float y = y0 + y1;
                const float mean = wave_sum(y) * (1.f / 64.f); const float d = y - mean; const float var = wave_sum(d * d) * (1.f / 64.f);
                const float yn = d * (1.0f / sqrtf(var + GN_EPS)) * gn_g + gn_b;
                outB[m * 512 + c] = (bf16)f2bf((yn + Lrk[t] * vt) * Lg[t * 64 + lane]); }
        }
        LDS_WAIT(); asm volatile("" ::: "memory");
    }
    if (MODE == 1 || MODE == 2) { float* dst = (MODE == 1) ? QS : PM;
#pragma unroll
        for (int k4 = 0; k4 < 16; ++k4) *(f32x4*)(dst + 4 * k4) = (f32x4){S[4 * k4], S[4 * k4 + 1], S[4 * k4 + 2], S[4 * k4 + 3]};
    }
}
__device__ __forceinline__ void rwkv_p2_wave(const Frame& F, int row, LAS float* Ls) {
    const int bh = row >> 6, v = row & 63, lane = F.lane;
    const float* PM = (const float*)(F.ws + WS_PM) + (size_t)bh * NCH * 4096 + lane; float* QS = (float*)(F.ws + WS_QS) + (size_t)bh * NCH * 4096 + v * 64 + lane;
    float s = 0.f;
    float pa[64];
#pragma unroll
    for (int k = 0; k < 64; ++k) pa[k] = PM[k * 64];
#pragma unroll 1
    for (int cc = 0; cc < NCH; ++cc) {
        const float q = QS[(size_t)cc * 4096];
        QS[(size_t)cc * 4096] = s;
        Ls[lane] = s;
        float pb[64]; const float* PMn = PM + (size_t)((cc + 1 < NCH) ? cc + 1 : cc) * 4096;
#pragma unroll
        for (int k = 0; k < 64; ++k) pb[k] = PMn[k * 64];
        LDS_WAIT(); asm volatile("" ::: "memory");
        float a0 = q, a1 = 0.f, a2 = 0.f, a3 = 0.f;
#pragma unroll
        for (int k4 = 0; k4 < 16; ++k4) { const f32x4 x = *(const LAS f32x4*)(Ls + 4 * k4); a0 += x[0] * pa[4 * k4]; a1 += x[1] * pa[4 * k4 + 1]; a2 += x[2] * pa[4 * k4 + 2]; a3 += x[3] * pa[4 * k4 + 3]; }
        s = (a0 + a1) + (a2 + a3);
#pragma unroll
        for (int k = 0; k < 64; ++k) pa[k] = pb[k];
        LDS_WAIT(); asm volatile("" ::: "memory");
    }
}

constexpr int PPL = 11;
constexpr int N_PHASES = 2 + PPL * DEPTH;
#ifndef NEW_ATT
#define NEW_ATT 1
#endif
#ifndef NEW_GLA
#define NEW_GLA 1
#endif
#ifndef NEW_RWKV
#define NEW_RWKV 1
#endif
__global__ void __launch_bounds__(NTHR, 2) mk_fwd(Args args) {
    extern __shared__ __attribute__((aligned(16))) unsigned char lds_raw[];
    Frame F;
    F.lds = (LAS unsigned char*)lds_raw; F.tid = threadIdx.x; F.lane = F.tid & 63; F.wave = __builtin_amdgcn_readfirstlane(F.tid >> 6);
    F.bid = blockIdx.x; F.G = gridDim.x; F.in = args.in; F.out = args.out; F.ws = args.ws;
    volatile LAS unsigned* MISC = (volatile LAS unsigned*)(F.lds + MISC_OFF);
    if (F.tid < 32) MISC[F.tid] = 0u;
    __syncthreads();
    const int lo = args.ph_lo, hi = args.ph_hi;
    XcdBarrier bar; bar.bar = (unsigned*)(F.ws + WS_CTL) + CW_BAR; bar.x = 0; bar.st = nullptr;
    if (hi - lo > 1) bar = xcd_barrier_post((unsigned*)(F.ws + WS_CTL) + CW_BAR, MISC + 8);
#define IN(k) (lo <= (k) && (k) < hi)
#ifndef EN_MASK
#define EN_MASK 0xFFF
#endif
#define EN(i) ((EN_MASK >> (i)) & 1)
#define SEAM(k) do { if (IN(k) && IN((k) + 1)) xcd_barrier(bar); } while (0)
#define PHASE_PTRS() Frame Fl = F; Fl.ws = launder(F.ws); Fl.out = launder(F.out); { int t_ = threadIdx.x; asm volatile("" : "+v"(t_)); Fl.tid = t_; Fl.lane = t_ & 63; Fl.wave = __builtin_amdgcn_readfirstlane(t_ >> 6); } \
    const float* mod = (const float*)(Fl.ws + WS_MOD); bf16* P = (bf16*)(Fl.ws + WS_P); bf16* UB = (bf16*)(Fl.ws + WS_UB); bf16* BR = (bf16*)(Fl.ws + WS_BR); \
    float* H = (float*)(Fl.ws + WS_H); bf16* HID = (bf16*)(Fl.ws + WS_HID); (void)mod; (void)P; (void)UB; (void)BR; (void)H; (void)HID;
    if (IN(0) && EN(0)) { phase_mod(F); } SEAM(0);
    if (IN(1) && EN(1)) { convert_weights(F, 0); make_u0(F); } SEAM(1);
#pragma unroll 1
    for (int l = 0; l < DEPTH; ++l) {
        const int pb = 2 + PPL * l;
        if (IN(pb + 0) && EN(2)) { PHASE_PTRS(); pg8::Gemm g{UB, (const bf16*)(Fl.ws + WS_WIN), M, NP, D}; pg8::StaticOrder S; S.init(M, NP, F.G, F.bid);
            pg8::EpiBf16<0> E{P, NP, nullptr, 0, 0, 1.f};
            pg8::gemm_phase<pg8::EpiBf16<0>, pg8::StaticOrder, true, true>(F.lds, g, S, E); }
        SEAM(pb + 0);
        if (IN(pb + 1) && EN(3)) { PHASE_PTRS(); phase_rwprep(Fl, l);
#if NEW_ATT == 1
            { LAS float* Lw = (LAS float*)(F.lds + Fl.wave * 16384);
              for (int u = F.bid * NWAVES + Fl.wave; u < 4096; u += F.G * NWAVES) attn_unit(Fl, 0, u, (LAS bf16*)Lw); }
#endif
        }
        SEAM(pb + 1);
        if (IN(pb + 2) && EN(4)) { PHASE_PTRS(); LAS float* Lw = (LAS float*)(F.lds + Fl.wave * 16384);
#if NEW_RWKV == 0
            if (F.bid < 16) { if (Fl.wave == 0) rwkv_scan_wave(Fl, l, F.bid); }
#endif
#if NEW_GLA == 0
            if (F.bid >= 16 && F.bid < 32) { if (Fl.wave == 0) gla_scan_wave(Fl, l, F.bid - 16); }
#endif
#if NEW_ATT == 0
            if (F.bid >= 32) attn_waves(Fl, (F.bid - 32) * NWAVES + Fl.wave, (F.G - 32) * NWAVES);
#endif
            __syncthreads();
            const int gw = F.bid * NWAVES + Fl.wave, NGW = F.G * NWAVES;
            if (NEW_RWKV == 1) { for (int u = gw; u < 2048; u += NGW) rwkv_chunk<1>(Fl, l, u, Lw); }
            if (NEW_RWKV == 1) { for (int u = gw; u < 2048; u += NGW) rwkv_chunk<2>(Fl, l, u, Lw); }
            if (NEW_GLA == 1) { for (int u = gw; u < 1024; u += NGW) gla_chunk<1>(Fl, l, u, Lw); }
            if (NEW_ATT == 1) { for (int u = (gw + 1024) % NGW; u < 4096; u += NGW) attn_unit(Fl, 1, u, (LAS bf16*)Lw); }
            __syncthreads();
        }
        SEAM(pb + 2);
        if (IN(pb + 3) && EN(5)) { PHASE_PTRS(); LAS float* Lw = (LAS float*)(F.lds + Fl.wave * 16384);
#if NEW_GLA == 0
            phase_gla_post(Fl, l);
#endif
            if (F.bid < 128) { if (NEW_RWKV == 1) rwkv_p2_wave(Fl, F.bid * NWAVES + Fl.wave, Lw); }
            else { if (NEW_GLA == 1) gla_p2(Fl, (F.bid - 128) * NTHR + Fl.tid);
                   if (NEW_ATT == 1) for (int u = (F.bid - 128) * NWAVES + Fl.wave; u < 4096; u += 128 * NWAVES) attn_unit(Fl, 2, u, (LAS bf16*)Lw); }
            __syncthreads();
        }
        SEAM(pb + 3);
        if (IN(pb + 4) && EN(5)) { PHASE_PTRS(); LAS float* Lw = (LAS float*)(F.lds + Fl.wave * 16384);
            const int gw = F.bid * NWAVES + Fl.wave, NGW = F.G * NWAVES;
            if (NEW_RWKV == 1) { for (int u = gw; u < 2048; u += NGW) rwkv_chunk<3>(Fl, l, u, Lw); }
            if (NEW_GLA == 1) { for (int u = gw; u < 1024; u += NGW) gla_chunk<3>(Fl, l, u, Lw); }
            __syncthreads();
        }
        SEAM(pb + 4);
        if (IN(pb + 5) && EN(6)) {
#pragma unroll 1
            for (int n = 0; n < 3; ++n) { PHASE_PTRS(); pg8::Gemm g{BR + (size_t)n * M * 512, (const bf16*)(Fl.ws + WS_WBR) + (size_t)n * 1024 * 512, M, D, 512}; pg8::StaticOrder S; S.init(M, D, F.G, F.bid);
                pg8::EpiBranch E{P + C_GATE + n * 1024, NP, (float*)(Fl.ws + WS_TMP), UB, n};
                pg8::gemm_phase<pg8::EpiBranch, pg8::StaticOrder, false, true>(F.lds, g, S, E);
                asm volatile("s_waitcnt vmcnt(0)" ::: "memory"); __syncthreads(); }
        }
        SEAM(pb + 5);
        if (IN(pb + 6) && EN(7)) { PHASE_PTRS(); pg8::Gemm g{UB, (const bf16*)(Fl.ws + WS_WOUT), M, D, D}; pg8::StaticOrder S; S.init(M, D, F.G, F.bid);
            pg8::EpiF32 E{H, D};
            pg8::gemm_phase<pg8::EpiF32, pg8::StaticOrder, false, true>(F.lds, g, S, E); }
        SEAM(pb + 6);
        if (IN(pb + 7) && EN(8)) { PHASE_PTRS(); const float* xold = (l == 0) ? launder(F.in[I_X]) : (const float*)Fl.out;
            phase_ln(Fl, xold, H, mod + (size_t)l * 2 * 6144 + 2 * 1024, launder(F.in[I_LN1G]) + l * D, launder(F.in[I_LN1B]) + l * D, Fl.out, mod + (size_t)l * 2 * 6144 + 3 * 1024, UB); }
        SEAM(pb + 7);
        if (IN(pb + 8) && EN(9)) { PHASE_PTRS(); pg8::Gemm g{UB, (const bf16*)(Fl.ws + WS_W1), M, 2 * FFH, D}; pg8::StaticOrder S; S.init(M, 2 * FFH, F.G, F.bid);
            pg8::EpiSwiglu E{HID, FFH};
            pg8::gemm_phase<pg8::EpiSwiglu, pg8::StaticOrder, true, true>(F.lds, g, S, E); }
        SEAM(pb + 8);
        if (IN(pb + 9) && EN(10)) { PHASE_PTRS(); pg8::Gemm g{HID, (const bf16*)(Fl.ws + WS_W2), M, D, FFH}; pg8::StaticOrder S; S.init(M, D, F.G, F.bid);
            pg8::EpiF32 E{H, D};
            pg8::gemm_phase<pg8::EpiF32, pg8::StaticOrder, false, true>(F.lds, g, S, E); }
        SEAM(pb + 9);
        if (IN(pb + 10) && EN(11)) { PHASE_PTRS();
            const float* nsh = (l + 1 < DEPTH) ? mod + (size_t)(l + 1) * 2 * 6144 : nullptr;
            phase_ln(Fl, Fl.out, H, mod + (size_t)l * 2 * 6144 + 5 * 1024, launder(F.in[I_LN2G]) + l * D, launder(F.in[I_LN2B]) + l * D, Fl.out, nsh, UB);
            if (l + 1 < DEPTH) convert_weights(Fl, l + 1);
        }
        SEAM(pb + 10);
    }
#undef IN
#undef SEAM
}

extern "C" void kernel_launch(void* const* d_in, const int* in_sizes, int n_in, void* d_out, int out_size, void* d_ws, size_t ws_size, hipStream_t stream) {
    static int grid = 0;
    if (grid == 0) {
        if (n_in != N_IN || in_sizes[0] != M * D || out_size != M * D || ws_size < WS_END) { fprintf(stderr, "kernel_launch: unexpected shapes (n_in %d, in0 %d, out %d, ws %zu, need %zu)\n", n_in, n_in > 0 ? in_sizes[0] : -1, out_size, ws_size, (size_t)WS_END); grid = -1; return; }
        int dev = 0, cus = 0, per_cu = 0;
        if (hipGetDevice(&dev) != hipSuccess || hipDeviceGetAttribute(&cus, hipDeviceAttributeMultiprocessorCount, dev) != hipSuccess) { grid = -1; return; }
        if (hipFuncSetAttribute((const void*)mk_fwd, hipFuncAttributeMaxDynamicSharedMemorySize, LDS_BYTES) != hipSuccess) { fprintf(stderr, "kernel_launch: hipFuncSetAttribute failed\n"); grid = -1; return; }
        if (hipOccupancyMaxActiveBlocksPerMultiprocessor(&per_cu, (const void*)mk_fwd, NTHR, LDS_BYTES) != hipSuccess || per_cu < 1) fprintf(stderr, "kernel_launch: occupancy query says %d\n", per_cu);
        (void)hipGetLastError();
        grid = 256;
        if (cus < 256) { fprintf(stderr, "kernel_launch: %d CUs < 256\n", cus); grid = -1; return; }
    }
    if (grid < 0) return;
    (void)hipMemsetAsync((char*)d_ws + WS_CTL, 0, CTL_ZERO_BYTES, stream);
    Args a{};
    for (int i = 0; i < N_IN; ++i) a.in[i] = (const float*)d_in[i];
    a.out = (float*)d_out; a.ws = (unsigned char*)d_ws;
#if MK_ONE_LAUNCH
    a.ph_lo = 0; a.ph_hi = N_PHASES;
    hipLaunchKernelGGL(mk_fwd, dim3(grid), dim3(NTHR), LDS_BYTES, stream, a);
#else
    for (int k = 0; k < N_PHASES; ++k) { a.ph_lo = k; a.ph_hi = k + 1; hipLaunchKernelGGL(mk_fwd, dim3(grid), dim3(NTHR), LDS_BYTES, stream, a); }
#endif
}
```

```cpp
#define MK_ONE_LAUNCH 1
#include <hip/hip_runtime.h>
#include <cstdio>
#include <cstdint>
namespace pg8 {
#define PG8_LAS __attribute__((address_space(3)))
typedef unsigned short bf16_t;
typedef short bf16x8 __attribute__((ext_vector_type(8)));
typedef float f32x4 __attribute__((ext_vector_type(4)));
typedef unsigned u32x4 __attribute__((ext_vector_type(4)));
constexpr int BM = 256, BK = 64, HALF = 128, HTB = HALF * BK * 2  , STAGE_BYTES = 8 * HTB, NXCD = 8, WGM = 8;

__host__ __device__ __forceinline__ int lds_byte(int r, int c) { const int st = (r >> 4) * 2 + (c >> 5), rr = r & 15, cc = c & 31, ob = rr * 64 + cc * 2; return st * 1024 + (ob ^ (((ob >> 9) & 1) << 5)); }
__host__ __device__ __forceinline__ void stage_rc(int b, int& R, int& C) { const int st = b / 1024, sb = b % 1024, swz = sb ^ (((sb >> 9) & 1) << 5); R = (st >> 1) * 16 + swz / 64; C = (st & 1) * 32 + (swz % 64) / 2; }
__host__ __device__ __forceinline__ int perm32(int rho) { const int n = rho >> 4, i = rho & 15; return 8 * (i >> 2) + 4 * n + (i & 3); }

struct Unit { int pm, pn; };
struct Gemm { const bf16_t* A; const bf16_t* Bt; int M, N, K; };

struct StaticOrder {
    int nM, nN, nwg, G, c;
    __host__ __device__ void init(int M, int N, int G_, int c_) { nM = M / BM; nN = N / BM; nwg = nM * nN; G = G_; c = c_; }
    __host__ __device__ bool next(int i, Unit& u) const {
        const long L = (long)i * G + c; if (L >= nwg) return false;
        int wgid = (int)L; { const int q = nwg / NXCD, r = nwg % NXCD, xcd = wgid % NXCD, off = wgid / NXCD; wgid = (xcd < r ? xcd * (q + 1) : r * (q + 1) + (xcd - r) * q) + off; }
        const int nig = WGM * nN, gid = wgid / nig, fm = gid * WGM, gsz = (nM - fm) < WGM ? (nM - fm) : WGM;
        u.pm = fm + ((wgid % nig) % gsz); u.pn = (wgid % nig) / gsz; return true;
    }
    __device__ __forceinline__ void a_ready(const Unit&) const {}
    __device__ __forceinline__ void done(const Unit&) const {}
};

__device__ __forceinline__ unsigned cvt_pk_bf16(float lo, float hi) { unsigned r; asm volatile("v_cvt_pk_bf16_f32 %0, %1, %2" : "=v"(r) : "v"(lo), "v"(hi)); return r; }
typedef float f32x2 __attribute__((ext_vector_type(2)));
__device__ __forceinline__ f32x2 gelu_pk(f32x2 v) {
    const f32x2 av = __builtin_elementwise_abs(v), d = av * 0.2316418882f + 1.0f;
    f32x2 t; t.x = __builtin_amdgcn_rcpf(d.x); t.y = __builtin_amdgcn_rcpf(d.y);
    f32x2 q = t * 0.5307027145f + (-0.7265760135f); q = q * t + 0.7107068705f; q = q * t + (-0.142248368f); q = q * t + 0.127414796f; q = q * t;
    const f32x2 s = (v * v) * (-0.72134752044f);
    f32x2 e; e.x = __builtin_amdgcn_exp2f(s.x); e.y = __builtin_amdgcn_exp2f(s.y);
    const f32x2 m = v * (q * e), r = v - m;
    f32x2 o; o.x = v.x < 0.f ? m.x : r.x; o.y = v.y < 0.f ? m.y : r.y; return o;
}

template <int ACT  > struct EpiBf16 {
    static constexpr bool PERM = true, AFTER_DRAIN = false, MIDK = false; static_assert(ACT == 0 || ACT == 1, "EpiBf16: ACT is 0 (none) or 1 (gelu_pk)");
    bf16_t* O; int ldc; const float* bias; int split_cols; size_t split_stride; float scale0;
    __device__ __forceinline__ void operator()(const f32x4 (&acc)[2][2][4][2], const Unit& u, int wr, int wc, int fr, int fq) const {
        const int row0 = u.pm * BM + wr * 64 + fr; int colt = u.pn * BM; bf16_t* base = O;
        float sc = 1.f; if (split_cols) { const int t = colt / split_cols; base += (size_t)t * split_stride; colt -= t * split_cols; if (t == 0) sc = scale0; }
        const int col0 = colt + wc * 32 + 8 * fq, bcol0 = u.pn * BM + wc * 32 + 8 * fq;
        f32x4 bv[2][2];
#pragma unroll
        for (int bj = 0; bj < 2; ++bj)
#pragma unroll
            for (int n = 0; n < 2; ++n) bv[bj][n] = bias ? *(const f32x4*)(bias + bcol0 + bj * HALF + 4 * n) : (f32x4){0.f, 0.f, 0.f, 0.f};
#pragma unroll
        for (int ai = 0; ai < 2; ++ai)
#pragma unroll
            for (int m = 0; m < 4; ++m) { bf16_t* rowp = base + (size_t)(row0 + ai * HALF + m * 16) * ldc + col0;
#pragma unroll
                for (int bj = 0; bj < 2; ++bj) { f32x4 v0 = acc[ai][bj][m][0] + bv[bj][0], v1 = acc[ai][bj][m][1] + bv[bj][1];
                    if (ACT == 1) { f32x2 a = gelu_pk((f32x2){v0[0], v0[1]}), b = gelu_pk((f32x2){v0[2], v0[3]}), c = gelu_pk((f32x2){v1[0], v1[1]}), d = gelu_pk((f32x2){v1[2], v1[3]});
                        v0 = (f32x4){a.x, a.y, b.x, b.y}; v1 = (f32x4){c.x, c.y, d.x, d.y}; }
                    v0 = v0 * sc; v1 = v1 * sc; u32x4 w; w.x = cvt_pk_bf16(v0[0], v0[1]); w.y = cvt_pk_bf16(v0[2], v0[3]); w.z = cvt_pk_bf16(v1[0], v1[1]); w.w = cvt_pk_bf16(v1[2], v1[3]);
                    *(u32x4*)(rowp + bj * HALF) = w; } }
    }
};

struct PanelStats {
    unsigned* xbuf;
    unsigned* cnt;
    unsigned* tmo;
    int ntn; float eps;
    unsigned code;
    __device__ __forceinline__ bool run(const f32x4 (&v)[2][2][4][2], const Unit& u, int wr, int wc, int fr, int fq, PG8_LAS unsigned char* lds, int wid, int lane) const {
        typedef float f32x2v __attribute__((ext_vector_type(2)));
        PG8_LAS f32x2v* P = (PG8_LAS f32x2v*)lds;
        PG8_LAS f32x2v* S = (PG8_LAS f32x2v*)(lds + 8192);
        PG8_LAS unsigned* flag = (PG8_LAS unsigned*)(lds + 8192 + 2048);
#pragma unroll
        for (int ai = 0; ai < 2; ++ai)
#pragma unroll
            for (int m = 0; m < 4; ++m) {
                float s = 0.f;
#pragma unroll
                for (int bj = 0; bj < 2; ++bj)
#pragma unroll
                    for (int n = 0; n < 2; ++n) { const f32x4 x = v[ai][bj][m][n]; s += (x[0] + x[1]) + (x[2] + x[3]); }
                s += __shfl_xor(s, 16); s += __shfl_xor(s, 32);
                const float mw = s * (1.0f / 64.0f); float q = 0.f;
#pragma unroll
                for (int bj = 0; bj < 2; ++bj)
#pragma unroll
                    for (int n = 0; n < 2; ++n) { const f32x4 d = v[ai][bj][m][n] - mw; q += (d[0] * d[0] + d[1] * d[1]) + (d[2] * d[2] + d[3] * d[3]); }
                q += __shfl_xor(q, 16); q += __shfl_xor(q, 32);
                if (fq == 0) P[(ai * HALF + wr * 64 + m * 16 + fr) * 4 + wc] = (f32x2v){mw, q};
            }
        asm volatile("s_waitcnt lgkmcnt(0)" ::: "memory"); __builtin_amdgcn_s_barrier(); asm volatile("" ::: "memory");
#if defined(BROKEN_EXCHANGE_NO_WAIT)
#warning BROKEN CONTROL BUILD: the row-statistics exchange does not wait; results are wrong by design
        if (blockIdx.x >= 64) { const long long t0_ = clock64(); while (clock64() - t0_ < 60000) __builtin_amdgcn_s_sleep(8); }
#endif
        const int row = wid * 32 + (lane & 31);
        if (lane < 32) {
            const f32x2v a = P[row * 4 + 0], b = P[row * 4 + 1], c = P[row * 4 + 2], d = P[row * 4 + 3];
            const float mt = (a.x + b.x + c.x + d.x) * 0.25f;
            const float da = a.x - mt, db = b.x - mt, dc = c.x - mt, dd = d.x - mt;
            const float m2 = (a.y + b.y) + (c.y + d.y) + 64.0f * ((da * da + db * db) + (dc * dc + dd * dd));
            unsigned long long* slot = (unsigned long long*)xbuf + ((size_t)(u.pm * BM + row) * 4 + u.pn);
            __hip_atomic_store(slot, ((unsigned long long)__float_as_uint(m2) << 32) | __float_as_uint(mt), __ATOMIC_RELAXED, __HIP_MEMORY_SCOPE_AGENT);
        }
        asm volatile("s_waitcnt vmcnt(0)" ::: "memory");
        if (lane == 0) __hip_atomic_fetch_add(cnt + 64 * u.pm, 1u, __ATOMIC_RELAXED, __HIP_MEMORY_SCOPE_AGENT);
        if (wid == 0) {
            bool dead = false; const unsigned long long t0 = __builtin_amdgcn_s_memrealtime(); const unsigned want = 8u * (unsigned)ntn;
            for (;;) {
#if defined(BROKEN_EXCHANGE_NO_WAIT)
                break;
#endif
                if ((unsigned)__builtin_amdgcn_readfirstlane(__hip_atomic_load(cnt + 64 * u.pm, __ATOMIC_RELAXED, __HIP_MEMORY_SCOPE_AGENT)) >= want) break;
                if (__builtin_amdgcn_s_memrealtime() - t0 > 2000000ull) {
                    if (lane == 0) { unsigned expect = 0u; __hip_atomic_compare_exchange_strong(tmo + 1, &expect, code | (unsigned)(u.pm & 0xff), __ATOMIC_RELAXED, __ATOMIC_RELAXED, __HIP_MEMORY_SCOPE_AGENT);
                                     __hip_atomic_store(tmo, 1u, __ATOMIC_RELAXED, __HIP_MEMORY_SCOPE_AGENT); }
                    dead = true; break; }
                __builtin_amdgcn_s_sleep(2);
            }
            __builtin_amdgcn_fence(__ATOMIC_ACQUIRE, "agent");
            if (lane == 0) flag[0] = dead ? 1u : 0u;
        }
        asm volatile("s_waitcnt vmcnt(0) lgkmcnt(0)" ::: "memory"); __builtin_amdgcn_s_barrier(); asm volatile("" ::: "memory");
        const bool bad = flag[0] != 0u;
        if (lane < 32) {
            const unsigned long long* slot = (const unsigned long long*)xbuf + (size_t)(u.pm * BM + row) * 4; float mt[4], m2[4]; float ms = 0.f;
#pragma unroll
            for (int t = 0; t < 4; ++t) { if (t < ntn) { const unsigned long long w = __hip_atomic_load(slot + t, __ATOMIC_RELAXED, __HIP_MEMORY_SCOPE_AGENT); mt[t] = __uint_as_float((unsigned)w); m2[t] = __uint_as_float((unsigned)(w >> 32)); } else { mt[t] = 0.f; m2[t] = 0.f; } ms += mt[t]; }
            const float mean = ms / (float)ntn; float q = 0.f;
#pragma unroll
            for (int t = 0; t < 4; ++t) if (t < ntn) { const float dm = mt[t] - mean; q += m2[t] + 256.0f * dm * dm; }
            S[row] = (f32x2v){mean, 1.0f / sqrtf(q / (256.0f * (float)ntn) + eps)};
        }
        asm volatile("s_waitcnt lgkmcnt(0)" ::: "memory"); __builtin_amdgcn_s_barrier(); asm volatile("" ::: "memory");
        return bad;
    }
};
struct EpiLnRes {
    static constexpr bool PERM = false, AFTER_DRAIN = true, MIDK = false;
    const float* base; float* out; int ldc; const float* bias; PanelStats st; unsigned poison;
    __device__ __forceinline__ void fused(f32x4 (&acc)[2][2][4][2], const Unit& u, int wr, int wc, int fr, int fq, PG8_LAS unsigned char* lds, int wid, int lane) const {
        typedef float f32x2v __attribute__((ext_vector_type(2)));
        const PG8_LAS f32x2v* S = (const PG8_LAS f32x2v*)(lds + 8192);
        const int col0 = u.pn * BM + wc * 32 + 4 * fq;
#pragma unroll
        for (int bj = 0; bj < 2; ++bj)
#pragma unroll
            for (int n = 0; n < 2; ++n) { const f32x4 bv = bias ? *(const f32x4*)(bias + col0 + bj * HALF + n * 16) : (f32x4){0.f, 0.f, 0.f, 0.f};
#pragma unroll
                for (int ai = 0; ai < 2; ++ai)
#pragma unroll
                    for (int m = 0; m < 4; ++m) acc[ai][bj][m][n] += bv; }
        f32x4 pre[4][2][2];
#pragma unroll
        for (int m = 0; m < 4; ++m) { const size_t off = (size_t)(u.pm * BM + wr * 64 + m * 16 + fr) * ldc + col0;
#pragma unroll
            for (int bj = 0; bj < 2; ++bj)
#pragma unroll
                for (int n = 0; n < 2; ++n) pre[m][bj][n] = *(const f32x4*)(base + off + bj * HALF + n * 16); }
        const bool bad = st.run(acc, u, wr, wc, fr, fq, lds, wid, lane) || poison != 0u;
        const float qnan = __builtin_nanf("");
#pragma unroll
        for (int ai = 0; ai < 2; ++ai)
#pragma unroll
            for (int m = 0; m < 4; ++m) { const int r = ai * HALF + wr * 64 + m * 16 + fr; const f32x2v sr = S[r]; const size_t off = (size_t)(u.pm * BM + r) * ldc + col0;
#pragma unroll
                for (int bj = 0; bj < 2; ++bj)
#pragma unroll
                    for (int n = 0; n < 2; ++n) { const f32x4 bs = ai == 0 ? pre[m][bj][n] : *(const f32x4*)(base + off + bj * HALF + n * 16); f32x4 o = bs + (acc[ai][bj][m][n] - sr.x) * sr.y;
                        if (bad) o = (f32x4){qnan, qnan, qnan, qnan}; *(f32x4*)(out + off + bj * HALF + n * 16) = o; }
                if (m & 1) asm volatile("" ::: "memory"); }
    }
};
struct EpiLnResLn {
    static constexpr bool PERM = false, AFTER_DRAIN = true, MIDK = false;
    const float* base; float* out; bf16_t* xn; int ldc; const float* bias; PanelStats st1, st2; unsigned poison;
    __device__ __forceinline__ void fused(f32x4 (&acc)[2][2][4][2], const Unit& u, int wr, int wc, int fr, int fq, PG8_LAS unsigned char* lds, int wid, int lane) const {
        typedef float f32x2v __attribute__((ext_vector_type(2))); typedef unsigned u32x2v __attribute__((ext_vector_type(2)));
        const PG8_LAS f32x2v* S = (const PG8_LAS f32x2v*)(lds + 8192);
        const int col0 = u.pn * BM + wc * 32 + 4 * fq;
#pragma unroll
        for (int bj = 0; bj < 2; ++bj)
#pragma unroll
            for (int n = 0; n < 2; ++n) { const f32x4 bv = bias ? *(const f32x4*)(bias + col0 + bj * HALF + n * 16) : (f32x4){0.f, 0.f, 0.f, 0.f};
#pragma unroll
                for (int ai = 0; ai < 2; ++ai)
#pragma unroll
                    for (int m = 0; m < 4; ++m) acc[ai][bj][m][n] += bv; }
        bool bad = st1.run(acc, u, wr, wc, fr, fq, lds, wid, lane) || poison != 0u;
        const float qnan = __builtin_nanf("");
#pragma unroll
        for (int ai = 0; ai < 2; ++ai)
#pragma unroll
            for (int m = 0; m < 4; ++m) { const int r = ai * HALF + wr * 64 + m * 16 + fr; const f32x2v sr = S[r]; const size_t off = (size_t)(u.pm * BM + r) * ldc + col0;
#pragma unroll
                for (int bj = 0; bj < 2; ++bj)
#pragma unroll
                    for (int n = 0; n < 2; ++n) { const f32x4 bs = *(const f32x4*)(base + off + bj * HALF + n * 16); acc[ai][bj][m][n] = bs + (acc[ai][bj][m][n] - sr.x) * sr.y; }
                asm volatile("" : "+v"(acc[ai][0][m][0]), "+v"(acc[ai][0][m][1]), "+v"(acc[ai][1][m][0]), "+v"(acc[ai][1][m][1]));
                if (m & 1) asm volatile("" ::: "memory"); }
        const bool bad1 = bad;
        bad = st2.run(acc, u, wr, wc, fr, fq, lds, wid, lane) || bad;
#pragma unroll
        for (int ai = 0; ai < 2; ++ai)
#pragma unroll
            for (int m = 0; m < 4; ++m) { const int r = ai * HALF + wr * 64 + m * 16 + fr; const f32x2v sr = S[r]; const size_t off = (size_t)(u.pm * BM + r) * ldc + col0;
#pragma unroll
                for (int bj = 0; bj < 2; ++bj)
#pragma unroll
                    for (int n = 0; n < 2; ++n) { const f32x4 x1 = acc[ai][bj][m][n]; *(f32x4*)(out + off + bj * HALF + n * 16) = bad1 ? (f32x4){qnan, qnan, qnan, qnan} : x1;
                        const f32x4 o = (x1 - sr.x) * sr.y; u32x2v w; w.x = cvt_pk_bf16(o[0], o[1]); w.y = cvt_pk_bf16(o[2], o[3]);
                        if (bad) { w.x = 0x7fc07fc0u; w.y = 0x7fc07fc0u; } *(u32x2v*)(xn + off + bj * HALF + n * 16) = w; }
                asm volatile("" ::: "memory"); }
    }
};

template <class Epi, class Sched, bool ALIGN_EPI = false, bool SP2 = false>
__device__ __forceinline__ void gemm_phase(PG8_LAS unsigned char* lds, const Gemm g, const Sched& S, const Epi& E, int wave_id) {
    int tid_ = (int)__builtin_amdgcn_mbcnt_hi(~0u, __builtin_amdgcn_mbcnt_lo(~0u, 0u)); asm volatile("" : "+v"(tid_)); tid_ += wave_id * 64;
    const int tid = tid_, wid = __builtin_amdgcn_readfirstlane(tid >> 6), lane = tid & 63, wr = wid >> 2, wc = wid & 3, fr = lane & 15, fq = lane >> 4;
    const int K = g.K, nt = K / BK;
    unsigned voffA[2], voffB[2];
#pragma unroll
    for (int i = 0; i < 2; ++i) { int R, C; stage_rc(tid * 16 + i * 8192, R, C); const int Rb = Epi::PERM ? ((R & ~31) + perm32(R & 31)) : R;
        voffA[i] = (unsigned)(R * K + C) * 2u; voffB[i] = (unsigned)(Rb * K + C) * 2u; }
    const size_t kstep = (size_t)(BK * 2);
    const size_t hstep = (size_t)HALF * K * 2;
    const size_t tstep = 2 * hstep;
    const unsigned ldsw = (unsigned)wid * 1024u;
    const int aoff = lds_byte(wr * 64 + fr, fq * 8), boff = lds_byte(wc * 32 + fr, fq * 8);
#define PG8_SA(b, h) (((b) * 2 + (h)) * HTB)
#define PG8_SB(b, h) ((4 + (b) * 2 + (h)) * HTB)
#define PG8_STAGE(bufoff, gbase, voff) do { _Pragma("unroll") for (int _i = 0; _i < 2; ++_i) \
        __builtin_amdgcn_global_load_lds((const unsigned*)((const char*)(gbase) + (voff)[_i]), (PG8_LAS unsigned*)(lds + (bufoff) + ldsw + _i * 8192), 16, 0, 0); } while (0)
#define PG8_LDA(dst, b, h) do { _Pragma("unroll") for (int m = 0; m < 4; ++m) _Pragma("unroll") for (int k = 0; k < 2; ++k) dst[m][k] = *(const PG8_LAS bf16x8*)(lds + PG8_SA(b, h) + aoff + m * 2048 + k * 1024); } while (0)
#define PG8_LDB(dst, b, h) do { _Pragma("unroll") for (int n = 0; n < 2; ++n) _Pragma("unroll") for (int k = 0; k < 2; ++k) dst[n][k] = *(const PG8_LAS bf16x8*)(lds + PG8_SB(b, h) + boff + n * 2048 + k * 1024); } while (0)
#define PG8_MMA(ai, bj, At, Bt) do { __builtin_amdgcn_s_setprio(1); _Pragma("unroll") for (int m = 0; m < 4; ++m) _Pragma("unroll") for (int n = 0; n < 2; ++n) _Pragma("unroll") for (int k = 0; k < 2; ++k) \
        acc[ai][bj][m][n] = __builtin_amdgcn_mfma_f32_16x16x32_bf16(Bt[n][k], At[m][k], acc[ai][bj][m][n], 0, 0, 0); __builtin_amdgcn_s_setprio(0); } while (0)
#define PG8_WAIT_V(n) asm volatile("s_waitcnt vmcnt(" #n ")" ::: "memory")
#define PG8_WAIT_L(n) asm volatile("s_waitcnt lgkmcnt(" #n ")" ::: "memory")
#define PG8_BAR __builtin_amdgcn_s_barrier()
#define PG8_SCHED __builtin_amdgcn_sched_barrier(0)
    Unit cur, nxt; int ui = 0;
    if (!S.next(0, cur)) return;
    f32x4 acc[2][2][4][2];
#pragma unroll
    for (int a = 0; a < 2; ++a)
#pragma unroll
        for (int b = 0; b < 2; ++b)
#pragma unroll
            for (int m = 0; m < 4; ++m)
#pragma unroll
                for (int n = 0; n < 2; ++n) acc[a][b][m][n] = (f32x4){0.f, 0.f, 0.f, 0.f};
    bf16x8 At[4][2], B0[2][2], B1[2][2];
    const char* cA = (const char*)g.A + (size_t)cur.pm * tstep; const char* cB = (const char*)g.Bt + (size_t)cur.pn * tstep;
    S.a_ready(cur);
    if constexpr (SP2) {
        PG8_STAGE(PG8_SB(0, 0), cB, voffB); PG8_STAGE(PG8_SB(0, 1), cB + hstep, voffB); PG8_STAGE(PG8_SA(0, 0), cA, voffA); PG8_STAGE(PG8_SA(0, 1), cA + hstep, voffA);
        if (wr == 1) PG8_BAR;
        PG8_WAIT_V(2); PG8_BAR;
        PG8_STAGE(PG8_SB(1, 0), cB + kstep, voffB); PG8_STAGE(PG8_SA(1, 0), cA + kstep, voffA); PG8_STAGE(PG8_SB(1, 1), cB + hstep + kstep, voffB);
        PG8_WAIT_V(6); PG8_BAR;
    } else {
        PG8_STAGE(PG8_SB(0, 0), cB, voffB); PG8_STAGE(PG8_SA(0, 0), cA, voffA); PG8_STAGE(PG8_SB(0, 1), cB + hstep, voffB); PG8_STAGE(PG8_SA(0, 1), cA + hstep, voffA);
        if (wr == 1) PG8_BAR;
        PG8_WAIT_V(4); PG8_BAR;
        PG8_STAGE(PG8_SB(1, 0), cB + kstep, voffB); PG8_STAGE(PG8_SA(1, 0), cA + kstep, voffA); PG8_STAGE(PG8_SB(1, 1), cB + hstep + kstep, voffB);
        PG8_WAIT_V(6); PG8_BAR;
    }
    for (;;) {
        const bool has_next = S.next(ui + 1, nxt);
        const char* nA = has_next ? (const char*)g.A + (size_t)nxt.pm * tstep : cA; const char* nB = has_next ? (const char*)g.Bt + (size_t)nxt.pn * tstep : cB;
        const int nseg = Epi::MIDK ? nt / 8 : 1, tl = Epi::MIDK ? 8 : nt;
#pragma unroll 1
        for (int seg = 0; seg < nseg; ++seg) {
        if constexpr (Epi::MIDK) { if (seg) E.mid(acc, cur, seg, wr, wc, fr, fq); }
#pragma unroll 1
        for (int t = seg * tl; t < (seg + 1) * tl; t += 2) {
            const bool last = (t == nt - 2);
            asm volatile("" : "+v"(voffA[0]), "+v"(voffA[1]), "+v"(voffB[0]), "+v"(voffB[1]));
            const char* a1 = cA + (size_t)(t + 1) * kstep;
            const char* a2 = last ? nA : cA + (size_t)(t + 2) * kstep; const char* b2 = last ? nB : cB + (size_t)(t + 2) * kstep;
            const char* a3 = a2 + kstep; const char* b3 = b2 + kstep;
            if (last && has_next) S.a_ready(nxt);
            if constexpr (SP2) {
            PG8_LDB(B0, 0, 0); PG8_LDB(B1, 0, 1); PG8_SCHED; PG8_LDA(At, 0, 0); PG8_STAGE(PG8_SA(1, 1), a1 + hstep, voffA);
            PG8_WAIT_V(8); PG8_WAIT_L(0); PG8_BAR; PG8_MMA(0, 0, At, B0); PG8_MMA(0, 1, At, B1); PG8_BAR; PG8_SCHED;
            PG8_LDA(At, 0, 1); PG8_STAGE(PG8_SB(0, 0), b2, voffB); PG8_STAGE(PG8_SB(0, 1), b2 + hstep, voffB); PG8_STAGE(PG8_SA(0, 0), a2, voffA);
            PG8_WAIT_V(8); PG8_WAIT_L(0); PG8_BAR; PG8_MMA(1, 0, At, B0); PG8_MMA(1, 1, At, B1); PG8_BAR; PG8_SCHED;
            PG8_LDB(B0, 1, 0); PG8_LDB(B1, 1, 1); PG8_SCHED; PG8_LDA(At, 1, 0); PG8_STAGE(PG8_SA(0, 1), a2 + hstep, voffA);
            PG8_WAIT_V(8); PG8_WAIT_L(0); PG8_BAR; PG8_MMA(0, 0, At, B0); PG8_MMA(0, 1, At, B1); PG8_BAR; PG8_SCHED;
            PG8_LDA(At, 1, 1); PG8_STAGE(PG8_SB(1, 0), b3, voffB); PG8_STAGE(PG8_SB(1, 1), b3 + hstep, voffB); PG8_STAGE(PG8_SA(1, 0), a3, voffA);
            PG8_WAIT_V(8); PG8_WAIT_L(0); PG8_BAR; PG8_MMA(1, 0, At, B0); PG8_MMA(1, 1, At, B1); PG8_BAR; PG8_SCHED;
            } else {
            PG8_LDB(B0, 0, 0); PG8_SCHED; PG8_LDA(At, 0, 0); PG8_STAGE(PG8_SA(1, 1), a1 + hstep, voffA);
            PG8_WAIT_L(8); PG8_BAR; PG8_WAIT_L(0); PG8_MMA(0, 0, At, B0); PG8_BAR; PG8_SCHED;
            PG8_LDB(B1, 0, 1); PG8_STAGE(PG8_SB(0, 0), b2, voffB);
            PG8_BAR; PG8_WAIT_L(0); PG8_MMA(0, 1, At, B1); PG8_BAR;
            PG8_LDA(At, 0, 1); PG8_STAGE(PG8_SA(0, 0), a2, voffA);
            PG8_BAR; PG8_WAIT_L(0); PG8_MMA(1, 0, At, B0); PG8_BAR; PG8_SCHED;
            PG8_STAGE(PG8_SB(0, 1), b2 + hstep, voffB);
            PG8_WAIT_V(6); PG8_BAR; PG8_MMA(1, 1, At, B1); PG8_BAR;
            PG8_LDB(B0, 1, 0); PG8_SCHED; PG8_LDA(At, 1, 0); PG8_STAGE(PG8_SA(0, 1), a2 + hstep, voffA);
            PG8_WAIT_L(8); PG8_BAR; PG8_WAIT_L(0); PG8_MMA(0, 0, At, B0); PG8_BAR; PG8_SCHED;
            PG8_LDB(B1, 1, 1); PG8_STAGE(PG8_SB(1, 0), b3, voffB);
            PG8_BAR; PG8_WAIT_L(0); PG8_MMA(0, 1, At, B1); PG8_BAR;
            PG8_LDA(At, 1, 1); PG8_STAGE(PG8_SA(1, 0), a3, voffA);
            PG8_BAR; PG8_WAIT_L(0); PG8_MMA(1, 0, At, B0); PG8_BAR; PG8_SCHED;
            PG8_STAGE(PG8_SB(1, 1), b3 + hstep, voffB);
            PG8_WAIT_V(6); PG8_BAR; PG8_MMA(1, 1, At, B1); PG8_BAR;
            }
        }
        }
        if constexpr (ALIGN_EPI) { if (wr == 0) PG8_BAR; }
        if constexpr (!Epi::AFTER_DRAIN) { E(acc, cur, wr, wc, fr, fq); S.done(cur); }
        if (!has_next) break;
#pragma unroll
        for (int a = 0; a < 2; ++a)
#pragma unroll
            for (int b = 0; b < 2; ++b)
#pragma unroll
                for (int m = 0; m < 4; ++m)
#pragma unroll
                    for (int n = 0; n < 2; ++n) acc[a][b][m][n] = (f32x4){0.f, 0.f, 0.f, 0.f};
        cur = nxt; cA = nA; cB = nB; ++ui;
        if constexpr (ALIGN_EPI) { if (wr == 1) PG8_BAR; }
    }
    PG8_WAIT_V(0);
    if constexpr (!ALIGN_EPI) { if (wr == 0) PG8_BAR; }
    PG8_BAR;
    if constexpr (Epi::AFTER_DRAIN) { E.fused(acc, cur, wr, wc, fr, fq, lds, wid, lane); S.done(cur); }
#undef PG8_SA
#undef PG8_SB
#undef PG8_STAGE
#undef PG8_LDA
#undef PG8_LDB
#undef PG8_MMA
#undef PG8_WAIT_V
#undef PG8_WAIT_L
#undef PG8_BAR
#undef PG8_SCHED
}
}

namespace pg8 {
__device__ __forceinline__ float bf2f(unsigned short b) { return __uint_as_float(((unsigned)b) << 16); }
__device__ __forceinline__ float sigmoidf_(float x) { return 1.0f / (1.0f + __expf(-x)); }
struct EpiF32 {
    static constexpr bool PERM = false, AFTER_DRAIN = false, MIDK = false;
    float* C; int ldc;
    __device__ __forceinline__ void operator()(const f32x4 (&acc)[2][2][4][2], const Unit& u, int wr, int wc, int fr, int fq) const {
        const int row0 = u.pm * BM + wr * 64 + fr, col0 = u.pn * BM + wc * 32 + 4 * fq;
#pragma unroll
        for (int ai = 0; ai < 2; ++ai)
#pragma unroll
            for (int m = 0; m < 4; ++m) { float* rowp = C + (size_t)(row0 + ai * HALF + m * 16) * ldc + col0;
#pragma unroll
                for (int bj = 0; bj < 2; ++bj)
#pragma unroll
                    for (int n = 0; n < 2; ++n) *(f32x4*)(rowp + bj * HALF + n * 16) = acc[ai][bj][m][n]; }
    }
};
struct EpiBranchK {
    static constexpr bool PERM = true, AFTER_DRAIN = false, MIDK = true;
    const bf16_t* gate; int ldg; bf16_t* out;
    __device__ __forceinline__ void mid(f32x4 (&acc)[2][2][4][2], const Unit& u, int seg, int wr, int wc, int fr, int fq) const {
        asm volatile("" : "+v"(fr));
        const int row0 = u.pm * BM + wr * 64 + fr, col0 = u.pn * BM + wc * 32 + 8 * fq;
#pragma unroll
        for (int ai = 0; ai < 2; ++ai)
#pragma unroll
            for (int m = 0; m < 4; ++m) { const bf16_t* gp = gate + (size_t)(row0 + ai * HALF + m * 16) * ldg + (seg - 1) * 1024 + col0;
#pragma unroll
                for (int bj = 0; bj < 2; ++bj) { const u32x4 a = *(const u32x4*)(gp + bj * HALF), b = *(const u32x4*)(gp + 1024 + bj * HALF);
#pragma unroll
                    for (int e = 0; e < 4; ++e) { const float a0 = __uint_as_float(a[e] << 16), a1 = __uint_as_float(a[e] & 0xffff0000u), b0 = __uint_as_float(b[e] << 16), b1 = __uint_as_float(b[e] & 0xffff0000u);
                        const float r0 = (1.0f + __expf(-b0)) / (1.0f + __expf(-a0)), r1 = (1.0f + __expf(-b1)) / (1.0f + __expf(-a1));
                        acc[ai][bj][m][e >> 1][(e & 1) * 2] *= r0; acc[ai][bj][m][e >> 1][(e & 1) * 2 + 1] *= r1; }
                    asm volatile("" : "+v"(acc[ai][bj][m][0]), "+v"(acc[ai][bj][m][1]) :: "memory"); __builtin_amdgcn_sched_barrier(0); } }
    }
    __device__ __forceinline__ void operator()(const f32x4 (&acc)[2][2][4][2], const Unit& u, int wr, int wc, int fr, int fq) const {
        asm volatile("" : "+v"(fr));
        const int row0 = u.pm * BM + wr * 64 + fr, col0 = u.pn * BM + wc * 32 + 8 * fq;
#pragma unroll
        for (int ai = 0; ai < 2; ++ai)
#pragma unroll
            for (int m = 0; m < 4; ++m) { const size_t r = (size_t)(row0 + ai * HALF + m * 16);
#pragma unroll
                for (int bj = 0; bj < 2; ++bj) { const u32x4 g = *(const u32x4*)(gate + r * ldg + 2048 + col0 + bj * HALF); float v[8];
#pragma unroll
                    for (int e = 0; e < 4; ++e) { v[2 * e] = acc[ai][bj][m][e >> 1][(e & 1) * 2] * sigmoidf_(__uint_as_float(g[e] << 16)); v[2 * e + 1] = acc[ai][bj][m][e >> 1][(e & 1) * 2 + 1] * sigmoidf_(__uint_as_float(g[e] & 0xffff0000u)); }
                    u32x4 w; w.x = cvt_pk_bf16(v[0], v[1]); w.y = cvt_pk_bf16(v[2], v[3]); w.z = cvt_pk_bf16(v[4], v[5]); w.w = cvt_pk_bf16(v[6], v[7]);
                    *(u32x4*)(out + r * 1024 + col0 + bj * HALF) = w; } }
    }
};
struct EpiSwiglu {
    static constexpr bool PERM = true, AFTER_DRAIN = false, MIDK = false;
    bf16_t* O; int ldc;
    __device__ __forceinline__ void operator()(const f32x4 (&acc)[2][2][4][2], const Unit& u, int wr, int wc, int fr, int fq) const {
        const int row0 = u.pm * BM + wr * 64 + fr, col0 = u.pn * HALF + wc * 32 + 8 * fq;
#pragma unroll
        for (int ai = 0; ai < 2; ++ai)
#pragma unroll
            for (int m = 0; m < 4; ++m) { bf16_t* rowp = O + (size_t)(row0 + ai * HALF + m * 16) * ldc + col0;
                float h[8];
#pragma unroll
                for (int n = 0; n < 2; ++n)
#pragma unroll
                    for (int i = 0; i < 4; ++i) { const float g = acc[ai][0][m][n][i], up = acc[ai][1][m][n][i]; h[n * 4 + i] = g * sigmoidf_(g) * up; }
                u32x4 w; w.x = cvt_pk_bf16(h[0], h[1]); w.y = cvt_pk_bf16(h[2], h[3]); w.z = cvt_pk_bf16(h[4], h[5]); w.w = cvt_pk_bf16(h[6], h[7]);
                *(u32x4*)rowp = w; }
    }
};
}

constexpr int BATCH = 2, SEQ = 8192, D = 1024, M = BATCH * SEQ, DEPTH = 4;
constexpr int NP = 8192;
constexpr int FFH = 2816;
constexpr int C_ATQ = 0, C_ATK = 512, C_ATV = 1024, C_GQ = 1536, C_GK = 1792, C_GV = 2048, C_GG = 2560;
constexpr int C_RR = 3072, C_RK = 3584, C_RV = 4096, C_RLO = 4608  , C_GA = 4864, C_GATE = 5120;
constexpr float LN_EPS = 1e-5f, GLA_EPS = 1e-5f, GN_EPS = 64e-5f;
constexpr float DN_ALPHA = 1.6817928305074290861f;

constexpr size_t MiB = 1u << 20;
constexpr size_t WS_CTL = 0, CTL_ZERO_BYTES = 1 * MiB;
constexpr size_t WS_MOD = 1 * MiB;
constexpr size_t WS_WIN = 2 * MiB;
constexpr size_t WS_WBR = WS_WIN + 16 * MiB;
constexpr size_t WS_WOUT = WS_WBR + 3 * MiB;
constexpr size_t WS_W1 = WS_WOUT + 2 * MiB;
constexpr size_t WS_W2 = WS_W1 + 11 * MiB;
constexpr size_t WS_LSE = 1 * MiB + 256 * 1024;
constexpr size_t WS_GDEC = 1 * MiB + 768 * 1024;
constexpr size_t WS_LORA = 39 * MiB + 512 * 1024;
constexpr size_t WS_UB = 40 * MiB;
constexpr size_t WS_PM = WS_UB;
constexpr size_t WS_BR = WS_UB + 32 * MiB;
constexpr size_t WS_RW = WS_BR + 48 * MiB;
constexpr size_t WS_QS = WS_RW + 48 * MiB;
constexpr size_t WS_DS = WS_QS + 32 * MiB;
constexpr size_t WS_GO = WS_DS;
constexpr size_t WS_TMP = WS_RW;
constexpr size_t WS_P = WS_DS + 32 * MiB;
constexpr size_t WS_H = WS_P;
constexpr size_t WS_HID = WS_P + 64 * MiB;
constexpr size_t WS_END = WS_P + 256 * MiB;
static_assert(WS_W2 + (size_t)1024 * 2816 * 2 <= WS_UB, "weights fit");
constexpr int CW_BAR = 4096;

#define LAS __attribute__((address_space(3)))
typedef unsigned short bf16;
typedef float f32x4 __attribute__((ext_vector_type(4)));
typedef unsigned v4u __attribute__((ext_vector_type(4)));
__device__ __forceinline__ float bf2f(bf16 b) { return __uint_as_float(((unsigned)b) << 16); }
__device__ __forceinline__ unsigned f2bf(float f) { unsigned u = __float_as_uint(f); return (u + 0x7fffu + ((u >> 16) & 1u)) >> 16; }
__device__ __forceinline__ unsigned pk2(float lo, float hi) { return f2bf(lo) | (f2bf(hi) << 16); }
__device__ __forceinline__ float sigm(float x) { return 1.0f / (1.0f + __expf(-x)); }
__device__ __forceinline__ float softplusf_(float x) { return fmaxf(x, 0.f) + log1pf(__expf(-fabsf(x))); }
__device__ __forceinline__ float wave_sum(float v) {
#pragma unroll
    for (int o = 1; o < 64; o <<= 1) v += __shfl_xor(v, o);
    return v;
}
__device__ __forceinline__ float wave_max(float v) {
#pragma unroll
    for (int o = 1; o < 64; o <<= 1) v = fmaxf(v, __shfl_xor(v, o));
    return v;
}
#define LDS_WAIT() asm volatile("s_waitcnt lgkmcnt(0)" ::: "memory")

template <class T> __device__ __forceinline__ T* launder(T* p) { __attribute__((address_space(1))) T* g = (__attribute__((address_space(1))) T*)p; asm volatile("" : "+s"(g)); return (T*)g; }
#define XB_TMO      128
#define XB_XCNT(j)  (256  + 64 * (j))
#define XB_XSUB(j)  (1280 + 64 * (j))
#define XB_XGEN(j)  (2304 + 64 * (j))
#define XB_TOP      3328
#define XB_TOPGEN   3392
#define XCD_BAR_WORDS 3456
#define XB_SPIN_CAP (1u << 18)
__device__ __forceinline__ unsigned xb_ld(unsigned* p)              { return __hip_atomic_load(p, __ATOMIC_RELAXED, __HIP_MEMORY_SCOPE_AGENT); }
__device__ __forceinline__ unsigned xb_add(unsigned* p, unsigned v) { return __hip_atomic_fetch_add(p, v, __ATOMIC_RELAXED, __HIP_MEMORY_SCOPE_AGENT); }
__device__ __forceinline__ unsigned xb_xcc_id() { return (unsigned)__builtin_amdgcn_s_getreg((3 << 11) | 20) & 0xFu; }
#define XB_SPIN(cond, bar) do { unsigned _sp = 0; while (cond) { __builtin_amdgcn_s_sleep(1); \
    if ((++_sp & 255u) == 0u) { if (xb_ld(&(bar)[XB_TMO])) break; if (_sp > XB_SPIN_CAP) { atomicAdd(&(bar)[XB_TMO], 1u); break; } } } } while (0)
struct XcdBarrier { unsigned* bar; unsigned x; volatile LAS unsigned* st; };
__device__ __forceinline__ XcdBarrier xcd_barrier_post(unsigned* bar, volatile LAS unsigned* st) {
    XcdBarrier b; b.bar = bar; b.x = xb_xcc_id(); b.st = st;
    if (threadIdx.x == 0) (void)xb_add(&bar[XB_XCNT(b.x)], 1u);
    return b;
}
__device__ __forceinline__ void xcd_barrier_complete(unsigned* bar, unsigned x, unsigned& nloc, unsigned& nx) {
    const unsigned G = gridDim.x * gridDim.y * gridDim.z;
    unsigned sum, cnt, mine, sp = 0u;
    for (;;) {
        sum = 0u; cnt = 0u; mine = 0u;
#pragma unroll 1
        for (unsigned j = 0; j < 16; ++j) { const unsigned c = xb_ld(&bar[XB_XCNT(j)]); sum += c; cnt += (c > 0u) ? 1u : 0u; mine = (j == x) ? c : mine; }
        if (sum == G) break;
        __builtin_amdgcn_s_sleep(1);
        if ((++sp & 255u) == 0u) { if (xb_ld(&bar[XB_TMO])) break; if (sp > XB_SPIN_CAP) { atomicAdd(&bar[XB_TMO], 1u); break; } }
    }
    nloc = mine > 0u ? mine : 1u; nx = cnt > 0u ? cnt : 1u;
}
__device__ __forceinline__ void xcd_barrier(const XcdBarrier& b, int wave_id) {
    asm volatile("s_waitcnt vmcnt(0)" ::: "memory");
    __syncthreads();
    if (wave_id == 0 && __builtin_amdgcn_mbcnt_hi(~0u, __builtin_amdgcn_mbcnt_lo(~0u, 0u)) == 0u) {
        unsigned* bar = launder(b.bar);
        __builtin_amdgcn_s_waitcnt(0);
        unsigned nloc = b.st[0], nx = b.st[1];
        if (nloc == 0u) { xcd_barrier_complete(bar, b.x, nloc, nx); b.st[0] = nloc; b.st[1] = nx; }
        const unsigned old = xb_add(&bar[XB_XSUB(b.x)], 1u);
        const unsigned gen = old / nloc;
        if (old + 1u == (gen + 1u) * nloc) {
            __builtin_amdgcn_fence(__ATOMIC_RELEASE, "agent");
            asm volatile("s_waitcnt vmcnt(0)" ::: "memory");
            const unsigned og = xb_add(&bar[XB_TOP], 1u);
            const unsigned tg = og / nx;
            if (og + 1u == (tg + 1u) * nx) xb_add(&bar[XB_TOPGEN], 1u);
            else XB_SPIN(xb_ld(&bar[XB_TOPGEN]) == tg, bar);
            __builtin_amdgcn_fence(__ATOMIC_ACQUIRE, "agent");
            xb_add(&bar[XB_XGEN(b.x)], 1u);
            asm volatile("s_waitcnt vmcnt(0)" ::: "memory");
        } else {
            XB_SPIN(xb_ld(&bar[XB_XGEN(b.x)]) == gen, bar);
            __builtin_amdgcn_fence(__ATOMIC_ACQUIRE, "agent");
            asm volatile("s_waitcnt vmcnt(0)" ::: "memory");
        }
    }
    __syncthreads();
}

constexpr int N_IN = 27;
enum { I_X = 0, I_C, I_WADA, I_BADA, I_WIN, I_GWA, I_GBA, I_GNG, I_RMU, I_RW0, I_RWUP, I_RA0, I_RAUP, I_RGUP, I_RKK, I_RKA, I_RRK, I_RGNG, I_RGNB, I_WBR, I_WOUT, I_LN1G, I_LN1B, I_W1, I_W2, I_LN2G, I_LN2B };
struct Args { const float* in[N_IN]; float* out; unsigned char* ws; int ph_lo, ph_hi; };
static_assert(sizeof(Args) == N_IN * 8 + 8 + 8 + 8, "Args has no padding");

constexpr int NWAVES = 8, NTHR = 512;
constexpr int RING_BYTES = 131072, MISC_OFF = RING_BYTES + 320, LDS_BYTES = 147456;

struct Frame {
    LAS unsigned char* lds; int tid, lane, wave, bid, G;
    const float* const* in; float* out; unsigned char* ws;
};

__device__ __forceinline__ void phase_mod(const Frame& F) {
    LAS float* sc = (LAS float*)F.lds;
    LAS float* part = sc + 2048;
    const float* c = F.in[I_C];
    for (int i = F.tid; i < 2048; i += NTHR) { const float v = c[i]; sc[i] = v * sigm(v); }
    __syncthreads();
    float* mod = (float*)(F.ws + WS_MOD);
    for (int item = F.bid; item < DEPTH * 96; item += F.G) {
        const int l = item / 96, cg = item % 96, col = cg * 64 + F.lane;
        const float* W = F.in[I_WADA] + (size_t)l * 1024 * 6144 + col;
        float s0 = 0.f, s1 = 0.f; const int k0 = F.wave * 128;
#pragma unroll 8
        for (int kk = 0; kk < 128; ++kk) { const int k = k0 + kk; const float w = W[(size_t)k * 6144]; s0 += sc[k] * w; s1 += sc[1024 + k] * w; }
        part[(F.wave * 2 + 0) * 64 + F.lane] = s0; part[(F.wave * 2 + 1) * 64 + F.lane] = s1;
        __syncthreads();
        if (F.wave < 2) { float t = 0.f;
#pragma unroll
            for (int w = 0; w < 8; ++w) t += part[(w * 2 + F.wave) * 64 + F.lane];
            mod[(size_t)(l * 2 + F.wave) * 6144 + col] = t + F.in[I_BADA][l * 6144 + col]; }
        __syncthreads();
    }
}
__device__ __forceinline__ int map_col(int mode, int n) {
    if (mode == 1) {
        if (n < 1536) return 3344 + n;
        if (n < 2560) return n - 1536;
        if (n < 3072) return 1040 + (n - 2560);
        if (n < 4864) return 1552 + (n - 3072);
        if (n < 4880) return 1024 + (n - 4864);
        if (n < 5120) return -1;
        return 4880 + (n - 5120);
    }
    if (mode == 2) { const int j = n >> 8, w = n & 255; return (w < 128) ? (j * 128 + w) : (FFH + j * 128 + (w - 128)); }
    return n;
}
__device__ __forceinline__ void transpose_item(const float* W, int K, int Nsrc, bf16* WT, int mode, int nblk, LAS float* scr, int item, int lane) {
    const int kb = item / nblk, nb = item % nblk, k0 = 64 * kb, n0 = 32 * nb;
    const int oc = map_col(mode, n0 + (lane & 31));
#pragma unroll 8
    for (int i = 0; i < 32; ++i) { const int kk = 2 * i + (lane >> 5); scr[kk * 33 + (lane & 31)] = (oc >= 0) ? W[(size_t)(k0 + kk) * Nsrc + oc] : 0.f; }
    LDS_WAIT(); asm volatile("" ::: "memory");
    const int c = lane & 7;
#pragma unroll
    for (int j = 0; j < 4; ++j) { const int n = (lane >> 3) + 8 * j; const LAS float* s = scr + (8 * c) * 33 + n;
        v4u o; o.x = pk2(s[0 * 33], s[1 * 33]); o.y = pk2(s[2 * 33], s[3 * 33]); o.z = pk2(s[4 * 33], s[5 * 33]); o.w = pk2(s[6 * 33], s[7 * 33]);
        *(v4u*)(WT + (size_t)(n0 + n) * K + k0 + 8 * c) = o; }
    LDS_WAIT(); asm volatile("" ::: "memory");
}
__device__ __forceinline__ void convert_weights(const Frame& F, int l) {
    LAS float* scr = (LAS float*)(F.lds + F.wave * 16384);
    const int gw = F.bid * NWAVES + F.wave, NGW = F.G * NWAVES;
    constexpr int I_IN = 16 * 256, I_BR = 8 * 32, I_OUT = 16 * 32, I_1 = 16 * 176, I_2 = 44 * 32;
    constexpr int I_L = 16 + 16 + 32;
    constexpr int NITEMS = I_IN + 3 * I_BR + I_OUT + I_1 + I_2 + I_L;
    for (int it = gw; it < NITEMS; it += NGW) {
        int r = it;
        if (r < I_IN) { transpose_item(F.in[I_WIN] + (size_t)l * 1024 * 7952, 1024, 7952, (bf16*)(F.ws + WS_WIN), 1, 256, scr, r, F.lane); continue; } r -= I_IN;
        if (r < 3 * I_BR) { transpose_item(F.in[I_WBR] + (size_t)l * 1536 * 1024, 1536, 1024, (bf16*)(F.ws + WS_WBR), 0, 32, scr, r, F.lane); continue; } r -= 3 * I_BR;
        if (r < I_OUT) { transpose_item(F.in[I_WOUT] + (size_t)l * 1024 * 1024, 1024, 1024, (bf16*)(F.ws + WS_WOUT), 0, 32, scr, r, F.lane); continue; } r -= I_OUT;
        if (r < I_1) { transpose_item(F.in[I_W1] + (size_t)l * 1024 * 5632, 1024, 5632, (bf16*)(F.ws + WS_W1), 2, 176, scr, r, F.lane); continue; } r -= I_1;
        if (r < I_2) { transpose_item(F.in[I_W2] + (size_t)l * 2816 * 1024, 2816, 1024, (bf16*)(F.ws + WS_W2), 0, 32, scr, r, F.lane); continue; } r -= I_2;
        if (r < 16) { transpose_item(F.in[I_RWUP] + (size_t)l * 64 * 512, 64, 512, (bf16*)(F.ws + WS_LORA), 0, 16, scr, r, F.lane); continue; } r -= 16;
        if (r < 16) { transpose_item(F.in[I_RAUP] + (size_t)l * 64 * 512, 64, 512, (bf16*)(F.ws + WS_LORA) + 512 * 64, 0, 16, scr, r, F.lane); continue; } r -= 16;
        transpose_item(F.in[I_RGUP] + (size_t)l * 128 * 512, 128, 512, (bf16*)(F.ws + WS_LORA) + 2 * 512 * 64, 0, 16, scr, r, F.lane);
    }
}
__device__ __forceinline__ void make_u0(const Frame& F) {
    const int gw = F.bid * NWAVES + F.wave, NGW = F.G * NWAVES;
    const float* mod = (const float*)(F.ws + WS_MOD);
    bf16* ub = (bf16*)(F.ws + WS_UB);
    for (int m = gw; m < M; m += NGW) {
        const int b = m / SEQ; const float* sh = mod + (size_t)(0 * 2 + b) * 6144; const float* scp = sh + 1024;
        const f32x4* xr = (const f32x4*)(F.in[I_X] + (size_t)m * D) + F.lane;
        unsigned long long* o8 = (unsigned long long*)(ub + (size_t)m * D) + F.lane;
#pragma unroll
        for (int j = 0; j < 4; ++j) { const f32x4 v = xr[64 * j]; const f32x4 s = *((const f32x4*)scp + F.lane + 64 * j), h = *((const f32x4*)sh + F.lane + 64 * j);
            const f32x4 u = v * (1.0f + s) + h;
            o8[64 * j] = (unsigned long long)pk2(u[0], u[1]) | ((unsigned long long)pk2(u[2], u[3]) << 32); }
    }
}
__device__ __forceinline__ void phase_ln(const Frame& F, const float* xold, const float* h, const float* gmod  , const float* lg, const float* lb,
                                         float* xout, const float* shmod  , bf16* ub) {
    const int gw = F.bid * NWAVES + F.wave, NGW = F.G * NWAVES;
    for (int m = gw; m < M; m += NGW) {
        const int b = m / SEQ;
        const f32x4* xr = (const f32x4*)(xold + (size_t)m * D) + F.lane; const f32x4* hr = (const f32x4*)(h + (size_t)m * D) + F.lane;
        const f32x4* gr = (const f32x4*)(gmod + (size_t)b * 6144) + F.lane;
        f32x4 v[4]; float s = 0.f;
#pragma unroll
        for (int j = 0; j < 4; ++j) { v[j] = DN_ALPHA * xr[64 * j] + (1.0f + gr[64 * j]) * hr[64 * j]; s += (v[j][0] + v[j][1]) + (v[j][2] + v[j][3]); }
        const float mean = wave_sum(s) * (1.f / D); float s2 = 0.f;
#pragma unroll
        for (int j = 0; j < 4; ++j) { v[j] = v[j] - mean; s2 += (v[j][0] * v[j][0] + v[j][1] * v[j][1]) + (v[j][2] * v[j][2] + v[j][3] * v[j][3]); }
        const float rstd = 1.f / sqrtf(wave_sum(s2) * (1.f / D) + LN_EPS);
        f32x4* xo = (f32x4*)(xout + (size_t)m * D) + F.lane;
        unsigned long long* o8 = (unsigned long long*)(ub + (size_t)m * D) + F.lane;
#pragma unroll
        for (int j = 0; j < 4; ++j) { const f32x4 y = v[j] * rstd * *((const f32x4*)lg + F.lane + 64 * j) + *((const f32x4*)lb + F.lane + 64 * j);
            xo[64 * j] = y;
            if (shmod) { const f32x4 sh = *((const f32x4*)(shmod + (size_t)b * 6144) + F.lane + 64 * j), sc = *((const f32x4*)(shmod + (size_t)b * 6144 + 1024) + F.lane + 64 * j);
                const f32x4 u = y * (1.0f + sc) + sh; o8[64 * j] = (unsigned long long)pk2(u[0], u[1]) | ((unsigned long long)pk2(u[2], u[3]) << 32); } }
    }
}

typedef short bf16x8 __attribute__((ext_vector_type(8)));
typedef float f32x16 __attribute__((ext_vector_type(16)));
typedef unsigned v2u __attribute__((ext_vector_type(2)));
constexpr int CH = 64, NCH = SEQ / CH;
__device__ __forceinline__ unsigned cvtpk(float lo, float hi) { unsigned r; asm volatile("v_cvt_pk_bf16_f32 %0, %1, %2" : "=v"(r) : "v"(lo), "v"(hi)); return r; }

__device__ __forceinline__ void rwprep_unit(const Frame& F, int l, int unit) {
    const int tt = unit >> 2, cq = unit & 3, lane = F.lane, rr = lane & 31, hh = lane >> 5;
    const size_t m = (size_t)tt * 32 + rr;
    const bf16* pc = (const bf16*)(F.ws + WS_P) + m * NP + C_RLO;
    const bool first = (m % SEQ) == 0;
    const float* mu = F.in[I_RMU] + l * 1792 + 1536;
    bf16x8 inf[16];
#pragma unroll
    for (int ks = 0; ks < 16; ++ks) { const int j0 = 16 * ks + 8 * hh;
        const v4u c = *(const v4u*)(pc + j0); v4u p = (v4u){0u, 0u, 0u, 0u}; if (!first) p = *(const v4u*)(pc - NP + j0);
        const f32x4 m0 = *(const f32x4*)(mu + j0), m1 = *(const f32x4*)(mu + j0 + 4);
        float x[8];
#pragma unroll
        for (int e = 0; e < 4; ++e) { const unsigned cw = c[e], pw = p[e];
            const float c0 = __uint_as_float(cw << 16), c1 = __uint_as_float(cw & 0xffff0000u), p0 = __uint_as_float(pw << 16), p1 = __uint_as_float(pw & 0xffff0000u);
            const float mu0 = (e < 2) ? m0[2 * e] : m1[2 * e - 4], mu1 = (e < 2) ? m0[2 * e + 1] : m1[2 * e - 3];
            x[2 * e] = c0 + (p0 - c0) * mu0; x[2 * e + 1] = c1 + (p1 - c1) * mu1; }
#pragma unroll
        for (int e = 0; e < 8; ++e) { if (ks < 4) x[e] = 1.0f - 2.0f / (__expf(2.0f * x[e]) + 1.0f); else if (ks >= 8) x[e] = sigm(x[e]); }
        union { unsigned u[4]; bf16x8 v; } pk;
#pragma unroll
        for (int e = 0; e < 4; ++e) pk.u[e] = cvtpk(x[2 * e], x[2 * e + 1]);
        inf[ks] = pk.v; }
    const bf16* wT = (const bf16*)(F.ws + WS_LORA); const bf16* aT = wT + 512 * 64; const bf16* gT = aT + 512 * 64;
    bf16* rw_lw = (bf16*)(F.ws + WS_RW); bf16* rw_a = rw_lw + (size_t)M * 512; bf16* rw_g = rw_a + (size_t)M * 512;
#pragma unroll 1
    for (int ct = 0; ct < 4; ++ct) { const int c0 = cq * 128 + ct * 32;
        f32x16 aw, aa, ag;
#pragma unroll
        for (int i = 0; i < 16; ++i) { aw[i] = 0.f; aa[i] = 0.f; ag[i] = 0.f; }
#pragma unroll
        for (int ks = 0; ks < 4; ++ks) { const bf16x8 fw = *(const bf16x8*)(wT + (size_t)(c0 + rr) * 64 + 16 * ks + 8 * hh), fa = *(const bf16x8*)(aT + (size_t)(c0 + rr) * 64 + 16 * ks + 8 * hh);
            aw = __builtin_amdgcn_mfma_f32_32x32x16_bf16(fw, inf[ks], aw, 0, 0, 0); aa = __builtin_amdgcn_mfma_f32_32x32x16_bf16(fa, inf[4 + ks], aa, 0, 0, 0); }
#pragma unroll
        for (int ks = 0; ks < 8; ++ks) { const bf16x8 fg = *(const bf16x8*)(gT + (size_t)(c0 + rr) * 128 + 16 * ks + 8 * hh); ag = __builtin_amdgcn_mfma_f32_32x32x16_bf16(fg, inf[8 + ks], ag, 0, 0, 0); }
#pragma unroll
        for (int g = 0; g < 4; ++g) { const int c = c0 + 8 * g + 4 * hh;
            const f32x4 w0 = *(const f32x4*)(F.in[I_RW0] + l * 512 + c), a0 = *(const f32x4*)(F.in[I_RA0] + l * 512 + c);
            float lw[4], av[4];
#pragma unroll
            for (int i = 0; i < 4; ++i) { const float wl = -softplusf_(-(w0[i] + aw[4 * g + i])) - 0.5f; lw[i] = -__expf(wl); av[i] = sigm(a0[i] + aa[4 * g + i]); }
            v2u o; o.x = cvtpk(lw[0], lw[1]); o.y = cvtpk(lw[2], lw[3]); *(v2u*)(rw_lw + m * 512 + c) = o;
            o.x = cvtpk(av[0], av[1]); o.y = cvtpk(av[2], av[3]); *(v2u*)(rw_a + m * 512 + c) = o;
            o.x = cvtpk(ag[4 * g], ag[4 * g + 1]); o.y = cvtpk(ag[4 * g + 2], ag[4 * g + 3]); *(v2u*)(rw_g + m * 512 + c) = o; }
    }
}

__device__ __forceinline__ void attn_unit(const Frame& F, int pi, int unit, LAS bf16* Vt) {
    const int dl = (pi == 0) ? 1 : ((pi == 1) ? 4 : 16), lg = (pi == 0) ? 0 : ((pi == 1) ? 2 : 4);
    const int bh = unit >> 8, rem = unit & 255, b = bh >> 3, h = bh & 7;
    const int per = 256 >> lg, res = rem / per, i0 = (rem % per) * 32;
    const int lane = F.lane, rr = lane & 31, hh = lane >> 5;
    const bf16* Pb = (const bf16*)(F.ws + WS_P) + ((size_t)b * SEQ + res) * NP;
    const size_t rstride = (size_t)dl * NP;
    const float slope = exp2f(-(float)(h + 1)) * (float)dl;
    bf16x8 qf[4];
    { const bf16* qp = Pb + (size_t)(i0 + rr) * rstride + C_ATQ + h * 64 + 8 * hh;
#pragma unroll
      for (int ks = 0; ks < 4; ++ks) qf[ks] = *(const bf16x8*)(qp + 16 * ks); }
    f32x16 o[2];
#pragma unroll
    for (int i = 0; i < 16; ++i) { o[0][i] = 0.f; o[1][i] = 0.f; }
    float mx = -1e30f, den = 0.f;
#pragma unroll 1
    for (int kt = (i0 >= 128 ? 0 : 4 - (i0 >> 5)); kt < 5; ++kt) {
        const int ik = i0 - 128 + 32 * kt + rr;
        const bf16* kp = Pb + (size_t)ik * rstride + C_ATK + h * 64 + 8 * hh;
        bf16x8 kf[4];
#pragma unroll
        for (int ks = 0; ks < 4; ++ks) kf[ks] = *(const bf16x8*)(kp + 16 * ks);
        const bf16* vp = Pb + (size_t)ik * rstride + C_ATV + h * 64;
        v4u vv[4];
#pragma unroll
        for (int i = 0; i < 4; ++i) vv[i] = *(const v4u*)(vp + 8 * (hh + 2 * i));
        f32x16 st;
#pragma unroll
        for (int i = 0; i < 16; ++i) st[i] = 0.f;
#pragma unroll
        for (int ks = 0; ks < 4; ++ks) st = __builtin_amdgcn_mfma_f32_32x32x16_bf16(kf[ks], qf[ks], st, 0, 0, 0);
        float tmx = -1e30f;
#pragma unroll
        for (int i = 0; i < 16; ++i) { const int keyrow = (i & 3) + 8 * (i >> 2) + 4 * hh; const int dist = rr + 128 - 32 * kt - keyrow;
            const bool valid = (dist >= 0) && (dist <= 128);
            const float sv = valid ? (st[i] * 0.125f - slope * (float)dist) : -1e30f; st[i] = sv; tmx = fmaxf(tmx, sv); }
        tmx = fmaxf(tmx, __shfl_xor(tmx, 32));
        const float mnew = fmaxf(mx, tmx); const float alpha = __expf(mx - mnew); mx = mnew;
        float ts = 0.f;
#pragma unroll
        for (int i = 0; i < 16; ++i) { const float p = (st[i] > -1e29f) ? __expf(st[i] - mnew) : 0.f; st[i] = p; ts += p; }
        ts += __shfl_xor(ts, 32);
        den = den * alpha + ts;
#pragma unroll
        for (int i = 0; i < 16; ++i) { o[0][i] *= alpha; o[1][i] *= alpha; }
#pragma unroll
        for (int i = 0; i < 4; ++i) { const int dg = hh + 2 * i; const v4u v = vv[i];
            LAS bf16* d = Vt + (8 * dg) * 36 + rr;
            d[0 * 36] = (bf16)(v.x & 0xffffu); d[1 * 36] = (bf16)(v.x >> 16); d[2 * 36] = (bf16)(v.y & 0xffffu); d[3 * 36] = (bf16)(v.y >> 16);
            d[4 * 36] = (bf16)(v.z & 0xffffu); d[5 * 36] = (bf16)(v.z >> 16); d[6 * 36] = (bf16)(v.w & 0xffffu); d[7 * 36] = (bf16)(v.w >> 16); }
        LDS_WAIT(); asm volatile("" ::: "memory");
#pragma unroll
        for (int sI = 0; sI < 2; ++sI) {
            union { unsigned u[4]; bf16x8 v; } pb;
#pragma unroll
            for (int j = 0; j < 4; ++j) pb.u[j] = cvtpk(st[8 * sI + 2 * j], st[8 * sI + 2 * j + 1]);
#pragma unroll
            for (int dt = 0; dt < 2; ++dt) { const LAS bf16* a = Vt + (rr + 32 * dt) * 36 + 16 * sI + 4 * hh;
                union { v2u q[2]; bf16x8 v; } af; af.q[0] = *(const LAS v2u*)a; af.q[1] = *(const LAS v2u*)(a + 8);
                o[dt] = __builtin_amdgcn_mfma_f32_32x32x16_bf16(af.v, pb.v, o[dt], 0, 0, 0); }
        }
        LDS_WAIT(); asm volatile("" ::: "memory");
    }
    const size_t mq = (size_t)b * SEQ + res + (size_t)dl * (i0 + rr);
    float* lsep = (float*)(F.ws + WS_LSE) + mq * 8 + h;
    bf16* op = (bf16*)(F.ws + WS_BR) + mq * 1536 + 1024 + h * 64 + 4 * hh;
    const float lse = mx + __logf(den); float wn = 1.0f / den, wo = 0.f;
    if (pi > 0) { const float lo_ = *lsep; const float ln = fmaxf(lo_, lse) + __logf(1.0f + __expf(-fabsf(lo_ - lse))); wo = __expf(lo_ - ln); wn = __expf(lse - ln) / den; if (hh == 0) *lsep = ln; }
    else if (hh == 0) *lsep = lse;
#pragma unroll
    for (int dt = 0; dt < 2; ++dt)
#pragma unroll
        for (int g = 0; g < 4; ++g) { bf16* p = op + 32 * dt + 8 * g; float v0 = o[dt][4 * g] * wn, v1 = o[dt][4 * g + 1] * wn, v2 = o[dt][4 * g + 2] * wn, v3 = o[dt][4 * g + 3] * wn;
            if (pi > 0) { const v2u ow = *(const v2u*)p; v0 += wo * __uint_as_float(ow.x << 16); v1 += wo * __uint_as_float(ow.x & 0xffff0000u); v2 += wo * __uint_as_float(ow.y << 16); v3 += wo * __uint_as_float(ow.y & 0xffff0000u); }
            v2u w; w.x = cvtpk(v0, v1); w.y = cvtpk(v2, v3); *(v2u*)p = w; }
}

template <int MODE>
__device__ __forceinline__ void gla_chunk(const Frame& F, int l, int unit, LAS float* Lw) {
    const int bh = unit >> 7, ch = unit & 127, b = bh >> 2, h = bh & 3, lane = F.lane, ck = h * 64 + lane;
    LAS float* La = Lw, *Lk = Lw + 512, *Lq = Lw + 1024, *Lv0 = Lw + 1536, *Lv1 = Lw + 2048, *Lg0 = Lw + 2560, *Lg1 = Lw + 3072, *Lga = Lw + 3584;
    const bf16* P = (const bf16*)(F.ws + WS_P);
    float* DS = (float*)(F.ws + WS_DS) + (size_t)unit * 64 * 128;
    const float* wa = F.in[I_GWA] + (size_t)l * 16 * 256; const float ba = F.in[I_GBA][l * 256 + ck];
    float war[16];
#pragma unroll
    for (int j = 0; j < 16; ++j) war[j] = wa[j * 256 + ck];
    float S0[64], S1[64];
    if (MODE == 1) {
#pragma unroll
        for (int k = 0; k < 64; ++k) { S0[k] = 0.f; S1[k] = 0.f; }
    } else {
#pragma unroll
        for (int k = 0; k < 64; ++k) { S0[k] = DS[k * 128 + lane]; S1[k] = DS[k * 128 + 64 + lane]; }
    }
    float ng0 = 0.f, ng1 = 0.f;
    if (MODE == 3) { ng0 = F.in[I_GNG][l * 128 + lane]; ng1 = F.in[I_GNG][l * 128 + 64 + lane]; }
    float lsum = 0.f;
    const size_t mc = (size_t)b * SEQ + ch * CH;
#pragma unroll 1
    for (int g = 0; g < 8; ++g) {
        const size_t m0 = mc + 8 * g;
        if (lane < 32) { const int t = lane >> 2, q = lane & 3; const v2u gw = *(const v2u*)(P + (m0 + t) * NP + C_GA + 4 * q);
            LAS float* d = Lga + t * 16 + 4 * q; d[0] = __uint_as_float(gw.x << 16); d[1] = __uint_as_float(gw.x & 0xffff0000u); d[2] = __uint_as_float(gw.y << 16); d[3] = __uint_as_float(gw.y & 0xffff0000u); }
#pragma unroll
        for (int t = 0; t < 8; ++t) { const bf16* pp = P + (m0 + t) * NP; Lk[t * 64 + lane] = bf2f(pp[C_GK + ck]); Lv0[t * 64 + lane] = bf2f(pp[C_GV + h * 128 + lane]); Lv1[t * 64 + lane] = bf2f(pp[C_GV + h * 128 + 64 + lane]);
            if (MODE == 3) { Lq[t * 64 + lane] = bf2f(pp[C_GQ + ck]) * 0.125f; Lg0[t * 64 + lane] = bf2f(pp[C_GG + h * 128 + lane]); Lg1[t * 64 + lane] = bf2f(pp[C_GG + h * 128 + 64 + lane]); } }
        LDS_WAIT(); asm volatile("" ::: "memory");
#pragma unroll
        for (int t = 0; t < 8; ++t) {
            float z = ba; const LAS f32x4* g4 = (const LAS f32x4*)(Lga + t * 16);
#pragma unroll
            for (int j4 = 0; j4 < 4; ++j4) { const f32x4 gq = g4[j4]; z += gq[0] * war[4 * j4] + gq[1] * war[4 * j4 + 1] + gq[2] * war[4 * j4 + 2] + gq[3] * war[4 * j4 + 3]; }
            const float ls = (fminf(z, 0.f) - log1pf(__expf(-fabsf(z)))) * (1.0f / 16.0f);
            lsum += ls; La[t * 64 + lane] = __expf(ls); }
        LDS_WAIT(); asm volatile("" ::: "memory");
#pragma unroll 1
        for (int t = 0; t < 8; ++t) {
            const LAS f32x4* q_a = (const LAS f32x4*)(La + t * 64); const LAS f32x4* q_k = (const LAS f32x4*)(Lk + t * 64); const LAS f32x4* q_q = (const LAS f32x4*)(Lq + t * 64);
            const float vt0 = Lv0[t * 64 + lane], vt1 = Lv1[t * 64 + lane]; float o0 = 0.f, o1 = 0.f;
#pragma unroll
            for (int k4 = 0; k4 < 16; ++k4) { const f32x4 a = q_a[k4], kk = q_k[k4]; f32x4 qq; if (MODE == 3) qq = q_q[k4];
#pragma unroll
                for (int i = 0; i < 4; ++i) { const float s0 = a[i] * S0[4 * k4 + i] + kk[i] * vt0, s1 = a[i] * S1[4 * k4 + i] + kk[i] * vt1; S0[4 * k4 + i] = s0; S1[4 * k4 + i] = s1;
                    if (MODE == 3) { o0 += qq[i] * s0; o1 += qq[i] * s1; } } }
            if (MODE == 3) {
                const float ms = wave_sum(o0 * o0 + o1 * o1) * (1.f / 128.f); const float rs = 1.0f / sqrtf(ms + GLA_EPS);
                const float gx0 = Lg0[t * 64 + lane], gx1 = Lg1[t * 64 + lane];
                bf16* ob = (bf16*)(F.ws + WS_BR) + (m0 + t) * 1536 + h * 128;
                ob[lane] = (bf16)f2bf(o0 * rs * ng0 * gx0 * sigm(gx0)); ob[64 + lane] = (bf16)f2bf(o1 * rs * ng1 * gx1 * sigm(gx1));
            }
        }
        LDS_WAIT(); asm volatile("" ::: "memory");
    }
    if (MODE == 1) {
#pragma unroll
        for (int k = 0; k < 64; ++k) { DS[k * 128 + lane] = S0[k]; DS[k * 128 + 64 + lane] = S1[k]; }
        ((float*)(F.ws + WS_GDEC))[unit * 64 + lane] = __expf(lsum);
    }
}
__device__ __forceinline__ void swap32(unsigned& a, unsigned& b) { auto r = __builtin_amdgcn_permlane32_swap(a, b, false, false); a = r[0]; b = r[1]; }
template <bool NEEDQ>
__device__ __forceinline__ void gla_prep16(const bf16* P16, int ck, const float (&war)[16], float ba, float& cs, float (&ke)[16], float (&qe)[16]) {
#pragma unroll
    for (int e = 0; e < 16; ++e) { const bf16* pp = P16 + (size_t)e * NP;
        const v4u g0 = *(const v4u*)(pp + C_GA), g1 = *(const v4u*)(pp + C_GA + 8);
        float z = ba;
#pragma unroll
        for (int j = 0; j < 4; ++j) { z += __uint_as_float(g0[j] << 16) * war[2 * j] + __uint_as_float(g0[j] & 0xffff0000u) * war[2 * j + 1];
                                      z += __uint_as_float(g1[j] << 16) * war[8 + 2 * j] + __uint_as_float(g1[j] & 0xffff0000u) * war[8 + 2 * j + 1]; }
        const float ls = (fminf(z, 0.f) - __logf(1.0f + __expf(-fabsf(z)))) * (1.0f / 16.0f);
        cs += ls;
        ke[e] = bf2f(pp[C_GK + ck]) * __expf(-cs);
        if (NEEDQ) qe[e] = bf2f(pp[C_GQ + ck]) * 0.125f * __expf(cs);
        if ((e & 3) == 3) asm volatile("" ::: "memory"); }
}
__device__ __forceinline__ void gla_p1m(const Frame& F, int l, int unit, LAS float* Lw) {
    const int bh = unit >> 7, ch = unit & 127, b = bh >> 2, h = bh & 3, lane = F.lane, rr = lane & 31, hh = lane >> 5, ck = h * 64 + lane;
    const bf16* Pc = (const bf16*)(F.ws + WS_P) + ((size_t)b * SEQ + ch * CH) * NP;
    const float* wa = F.in[I_GWA] + (size_t)l * 16 * 256; const float ba = F.in[I_GBA][l * 256 + ck];
    float war[16];
#pragma unroll
    for (int j = 0; j < 16; ++j) war[j] = wa[j * 256 + ck];
    LAS unsigned* Lk = (LAS unsigned*)(Lw + 64);
    float* DS = (float*)(F.ws + WS_DS) + (size_t)unit * 64 * 128;
    float cs = 0.f;
#pragma unroll 1
    for (int vh = 0; vh < 2; ++vh) {
        f32x16 acc[2][2];
#pragma unroll
        for (int kt = 0; kt < 2; ++kt)
#pragma unroll
            for (int vt = 0; vt < 2; ++vt)
#pragma unroll
                for (int i = 0; i < 16; ++i) acc[kt][vt][i] = 0.f;
#pragma unroll 1
        for (int ts = 0; ts < 4; ++ts) {
            const bf16* P16 = Pc + (size_t)(16 * ts) * NP;
            unsigned kp[8];
            if (vh == 0) {
                float ke[16], qd[16];
                gla_prep16<false>(P16, ck, war, ba, cs, ke, qd);
#pragma unroll
                for (int i = 0; i < 8; ++i) kp[i] = cvtpk(ke[2 * i], ke[2 * i + 1]);
#pragma unroll
                for (int q = 0; q < 4; ++q) swap32(kp[q], kp[4 + q]);
#pragma unroll
                for (int q = 0; q < 8; ++q) Lk[(ts * 8 + q) * 64 + lane] = kp[q];
            } else {
#pragma unroll
                for (int q = 0; q < 8; ++q) kp[q] = Lk[(ts * 8 + q) * 64 + lane];
            }
            const bf16* Pv = P16 + C_GV + h * 128 + vh * 64 + lane;
            unsigned vp[8];
#pragma unroll
            for (int i = 0; i < 8; ++i) vp[i] = (unsigned)Pv[(size_t)(2 * i) * NP] | ((unsigned)Pv[(size_t)(2 * i + 1) * NP] << 16);
#pragma unroll
            for (int q = 0; q < 4; ++q) swap32(vp[q], vp[4 + q]);
#pragma unroll
            for (int kt = 0; kt < 2; ++kt) { union { unsigned u[4]; bf16x8 v; } fa;
#pragma unroll
                for (int q = 0; q < 4; ++q) fa.u[q] = kp[4 * kt + q];
#pragma unroll
                for (int j2 = 0; j2 < 2; ++j2) { union { unsigned u[4]; bf16x8 v; } fb;
#pragma unroll
                    for (int q = 0; q < 4; ++q) fb.u[q] = vp[4 * j2 + q];
                    acc[kt][j2] = __builtin_amdgcn_mfma_f32_32x32x16_bf16(fa.v, fb.v, acc[kt][j2], 0, 0, 0); } }
        }
        if (vh == 0) { const float gam = __expf(cs); Lw[lane] = gam; ((float*)(F.ws + WS_GDEC))[unit * 64 + lane] = gam; }
        LDS_WAIT(); asm volatile("" ::: "memory");
#pragma unroll
        for (int kt = 0; kt < 2; ++kt)
#pragma unroll
            for (int g = 0; g < 4; ++g) { const int k0 = 32 * kt + 8 * g + 4 * hh; const f32x4 gm = *(const LAS f32x4*)(Lw + k0);
#pragma unroll
                for (int vt = 0; vt < 2; ++vt)
#pragma unroll
                    for (int i = 0; i < 4; ++i) DS[(k0 + i) * 128 + vh * 64 + 32 * vt + rr] = acc[kt][vt][4 * g + i] * gm[i]; }
    }
    LDS_WAIT(); asm volatile("" ::: "memory");
}
__device__ __forceinline__ void gla_p3m(const Frame& F, int l, int unit2, LAS unsigned char* Lb) {
    const int unit = unit2 >> 1, tt = unit2 & 1;
    const int bh = unit >> 7, ch = unit & 127, b = bh >> 2, h = bh & 3, lane = F.lane, rr = lane & 31, hh = lane >> 5;
    LAS unsigned char* KeN = Lb; LAS unsigned char* QeN = Lb + 8192;
    {
        const int ck = h * 64 + lane;
        const bf16* Pc = (const bf16*)(F.ws + WS_P) + ((size_t)b * SEQ + ch * CH) * NP;
        const float* wa = F.in[I_GWA] + (size_t)l * 16 * 256; const float ba = F.in[I_GBA][l * 256 + ck];
        float war[16];
#pragma unroll
        for (int j = 0; j < 16; ++j) war[j] = wa[j * 256 + ck];
        const int cb = ((lane >> 3) << 4), wb = (lane & 7) * 2;
        float cs = 0.f;
#pragma unroll 1
        for (int ts = 0; ts < 2 * tt + 2; ++ts) {
            float ke[16], qe[16];
            gla_prep16<true>(Pc + (size_t)(16 * ts) * NP, ck, war, ba, cs, ke, qe);
#pragma unroll
            for (int e = 0; e < 16; ++e) { const int t = 16 * ts + e; const int off = t * 128 + (cb ^ ((e & 7) << 4)) + wb;
                *(LAS bf16*)(KeN + off) = (bf16)(cvtpk(ke[e], 0.f) & 0xffffu); *(LAS bf16*)(QeN + off) = (bf16)(cvtpk(qe[e], 0.f) & 0xffffu); }
        }
    }
    LDS_WAIT(); asm volatile("" ::: "memory");
    const int tq = 32 * tt + rr;
    bf16x8 qf[4];
#pragma unroll
    for (int ks = 0; ks < 4; ++ks) qf[ks] = *(const LAS bf16x8*)(QeN + tq * 128 + (((2 * ks + hh) ^ (tq & 7)) << 4));
    f32x16 acc[4];
#pragma unroll
    for (int vt = 0; vt < 4; ++vt)
#pragma unroll
        for (int i = 0; i < 16; ++i) acc[vt][i] = 0.f;
    const float* DS = (const float*)(F.ws + WS_DS) + (size_t)unit * 64 * 128 + lane;
#pragma unroll 1
    for (int vh = 0; vh < 2; ++vh) {
        unsigned sp[32];
#pragma unroll
        for (int i = 0; i < 32; ++i) sp[i] = cvtpk(DS[(2 * i) * 128 + vh * 64], DS[(2 * i + 1) * 128 + vh * 64]);
#pragma unroll
        for (int ks = 0; ks < 4; ++ks)
#pragma unroll
            for (int q = 0; q < 4; ++q) swap32(sp[8 * ks + q], sp[8 * ks + 4 + q]);
#pragma unroll
        for (int ks = 0; ks < 4; ++ks)
#pragma unroll
            for (int j = 0; j < 2; ++j) { union { unsigned u[4]; bf16x8 v; } fa;
#pragma unroll
                for (int q = 0; q < 4; ++q) fa.u[q] = sp[8 * ks + 4 * j + q];
                if (vh == 0) acc[j] = __builtin_amdgcn_mfma_f32_32x32x16_bf16(fa.v, qf[ks], acc[j], 0, 0, 0);
                else acc[2 + j] = __builtin_amdgcn_mfma_f32_32x32x16_bf16(fa.v, qf[ks], acc[2 + j], 0, 0, 0); }
    }
    const bf16* Pv = (const bf16*)(F.ws + WS_P) + ((size_t)b * SEQ + ch * CH) * NP + C_GV + h * 128 + lane;
#pragma unroll 1
    for (int st = 0; st <= tt; ++st) {
        f32x16 at;
#pragma unroll
        for (int i = 0; i < 16; ++i) at[i] = 0.f;
        const int sr = 32 * st + rr;
#pragma unroll
        for (int ks = 0; ks < 4; ++ks) { const bf16x8 kf = *(const LAS bf16x8*)(KeN + sr * 128 + (((2 * ks + hh) ^ (sr & 7)) << 4));
            at = __builtin_amdgcn_mfma_f32_32x32x16_bf16(kf, qf[ks], at, 0, 0, 0); }
        if (st == tt) {
#pragma unroll
            for (int i = 0; i < 16; ++i) { const int srow = (i & 3) + 8 * (i >> 2) + 4 * hh; if (srow > rr) at[i] = 0.f; }
        }
        union { unsigned u[4]; bf16x8 v; } pb[2];
#pragma unroll
        for (int c = 0; c < 2; ++c)
#pragma unroll
            for (int q = 0; q < 4; ++q) pb[c].u[q] = cvtpk(at[8 * c + 2 * q], at[8 * c + 2 * q + 1]);
#pragma unroll 1
        for (int vh = 0; vh < 2; ++vh) {
            unsigned vp[16];
#pragma unroll
            for (int i = 0; i < 16; ++i) vp[i] = (unsigned)Pv[(size_t)(32 * st + 2 * i) * NP + vh * 64] | ((unsigned)Pv[(size_t)(32 * st + 2 * i + 1) * NP + vh * 64] << 16);
#pragma unroll
            for (int c = 0; c < 2; ++c) { swap32(vp[8 * c + 0], vp[8 * c + 2]); swap32(vp[8 * c + 1], vp[8 * c + 3]); swap32(vp[8 * c + 4], vp[8 * c + 6]); swap32(vp[8 * c + 5], vp[8 * c + 7]); }
#pragma unroll
            for (int c = 0; c < 2; ++c)
#pragma unroll
                for (int j = 0; j < 2; ++j) { union { unsigned u[4]; bf16x8 v; } fa; fa.u[0] = vp[8 * c + 2 * j]; fa.u[1] = vp[8 * c + 2 * j + 1]; fa.u[2] = vp[8 * c + 4 + 2 * j]; fa.u[3] = vp[8 * c + 5 + 2 * j];
                    if (vh == 0) acc[j] = __builtin_amdgcn_mfma_f32_32x32x16_bf16(fa.v, pb[c].v, acc[j], 0, 0, 0);
                    else acc[2 + j] = __builtin_amdgcn_mfma_f32_32x32x16_bf16(fa.v, pb[c].v, acc[2 + j], 0, 0, 0); }
        }
    }
    float ss = 0.f;
#pragma unroll
    for (int vt = 0; vt < 4; ++vt)
#pragma unroll
        for (int i = 0; i < 16; ++i) ss += acc[vt][i] * acc[vt][i];
    ss += __shfl_xor(ss, 32);
    const float rs = 1.0f / sqrtf(ss * (1.f / 128.f) + GLA_EPS);
    const size_t mq = (size_t)b * SEQ + ch * CH + tq;
    const bf16* gp = (const bf16*)(F.ws + WS_P) + mq * NP + C_GG + h * 128 + 4 * hh;
    bf16* ob = (bf16*)(F.ws + WS_BR) + mq * 1536 + h * 128 + 4 * hh;
    const float* ng = F.in[I_GNG] + l * 128 + 4 * hh;
#pragma unroll
    for (int vt = 0; vt < 4; ++vt)
#pragma unroll
        for (int g = 0; g < 4; ++g) { const int v0 = 32 * vt + 8 * g; const v2u gw = *(const v2u*)(gp + v0); const f32x4 n4 = *(const f32x4*)(ng + v0);
            const float g0 = __uint_as_float(gw.x << 16), g1 = __uint_as_float(gw.x & 0xffff0000u), g2 = __uint_as_float(gw.y << 16), g3 = __uint_as_float(gw.y & 0xffff0000u);
            v2u w; w.x = cvtpk(acc[vt][4 * g] * rs * n4[0] * g0 * sigm(g0), acc[vt][4 * g + 1] * rs * n4[1] * g1 * sigm(g1));
            w.y = cvtpk(acc[vt][4 * g + 2] * rs * n4[2] * g2 * sigm(g2), acc[vt][4 * g + 3] * rs * n4[3] * g3 * sigm(g3));
            *(v2u*)(ob + v0) = w; }
    LDS_WAIT(); asm volatile("" ::: "memory");
}
__device__ __forceinline__ void gla_p2(const Frame& F, int gid) {
    const int bh = gid >> 13, kv = gid & 8191, k = kv >> 7;
    float* DS = (float*)(F.ws + WS_DS) + (size_t)bh * NCH * 8192 + kv; const float* dec = (const float*)(F.ws + WS_GDEC) + (size_t)bh * NCH * 64 + k;
    float s = 0.f;
#pragma unroll 1
    for (int c0 = 0; c0 < NCH; c0 += 8) { float d[8], dc[8];
#pragma unroll
        for (int i = 0; i < 8; ++i) { d[i] = DS[(size_t)(c0 + i) * 8192]; dc[i] = dec[(c0 + i) * 64]; }
#pragma unroll
        for (int i = 0; i < 8; ++i) { DS[(size_t)(c0 + i) * 8192] = s; s = dc[i] * s + d[i]; } }
}

template <int MODE>
__device__ __forceinline__ void rwkv_chunk(const Frame& F, int l, int unit, LAS float* Lw) {
    const int bh = unit >> 7, ch = unit & 127, b = bh >> 3, h = bh & 7, lane = F.lane, c = h * 64 + lane;
    LAS float* Lkk = Lw, *Lwd = Lw + 512, *Lb = Lw + 1024, *Lk = Lw + 1536, *Lr = Lw + 2048, *Lv = Lw + 2560, *Lg = Lw + 3072, *Lrk = Lw + 3584;
    const bf16* P = (const bf16*)(F.ws + WS_P);
    const bf16* rw_lw = (const bf16*)(F.ws + WS_RW); const bf16* rw_a = rw_lw + (size_t)M * 512; const bf16* rw_g = rw_a + (size_t)M * 512;
    bf16* outB = (bf16*)(F.ws + WS_BR) + 512;
    float* QS = (float*)(F.ws + WS_QS) + ((size_t)unit * 64 + lane) * 64; float* PM = (float*)(F.ws + WS_PM) + ((size_t)unit * 64 + lane) * 64;
    const float* mu = F.in[I_RMU] + l * 1792;
    const float mu_r = mu[c], mu_k = mu[512 + c], mu_v = mu[1024 + c];
    const float k_k = F.in[I_RKK][l * 512 + c], k_a = F.in[I_RKA][l * 512 + c];
    float r_k = 0.f, gn_g = 0.f, gn_b = 0.f;
    if (MODE == 3) { r_k = F.in[I_RRK][l * 512 + c]; gn_g = F.in[I_RGNG][l * 512 + c]; gn_b = F.in[I_RGNB][l * 512 + c]; }
    float S[64];
    if (MODE == 1 || MODE == 2) {
        int ln_ = lane; asm volatile("" : "+v"(ln_));
#pragma unroll
        for (int k = 0; k < 64; ++k) S[k] = (MODE == 2 && k == ln_) ? 1.f : 0.f;
    } else {
#pragma unroll
        for (int k4 = 0; k4 < 16; ++k4) { const f32x4 x = *(const f32x4*)(QS + 4 * k4); S[4 * k4] = x[0]; S[4 * k4 + 1] = x[1]; S[4 * k4 + 2] = x[2]; S[4 * k4 + 3] = x[3]; }
    }
    const size_t mc = (size_t)b * SEQ + ch * CH;
    float pr = 0.f, pk = 0.f, pv = 0.f;
    if (ch > 0) { const bf16* pp = P + (mc - 1) * NP; pr = bf2f(pp[C_RR + c]); pk = bf2f(pp[C_RK + c]); pv = bf2f(pp[C_RV + c]); }
#pragma unroll 1
    for (int g = 0; g < 8; ++g) {
        const size_t m0 = mc + 8 * g;
#pragma unroll 1
        for (int tb = 0; tb < 8; tb += 4) {
        float cr[4], ck[4], cv[4], lw[4], av[4];
#pragma unroll
        for (int t = 0; t < 4; ++t) { const size_t m = m0 + tb + t; const bf16* pp = P + m * NP;
            ck[t] = bf2f(pp[C_RK + c]); cv[t] = bf2f(pp[C_RV + c]); lw[t] = bf2f(rw_lw[m * 512 + c]); av[t] = bf2f(rw_a[m * 512 + c]);
            if (MODE == 3) { cr[t] = bf2f(pp[C_RR + c]); Lg[(tb + t) * 64 + lane] = bf2f(rw_g[m * 512 + c]); } }
#pragma unroll
        for (int t = 0; t < 4; ++t) { const int tt = tb + t;
            const float k = ck[t] + (pk - ck[t]) * mu_k, v = cv[t] + (pv - cv[t]) * mu_v; pk = ck[t]; pv = cv[t];
            const float a = av[t];
            const float kkv = k * k_k; const float n2 = wave_sum(kkv * kkv); const float kk = kkv / fmaxf(sqrtf(n2), 1e-12f);
            const float kp = k * (1.0f + (a - 1.0f) * k_a);
            Lkk[tt * 64 + lane] = kk; Lwd[tt * 64 + lane] = __expf(lw[t]); Lb[tt * 64 + lane] = kk * a; Lk[tt * 64 + lane] = kp; Lv[tt * 64 + lane] = v;
            if (MODE == 3) { const float r = cr[t] + (pr - cr[t]) * mu_r; pr = cr[t]; Lr[tt * 64 + lane] = r; const float rk = wave_sum(r * kp * r_k); if (lane == 0) Lrk[tt] = rk; }
        }
        }
        LDS_WAIT(); asm volatile("" ::: "memory");
#pragma unroll 1
        for (int t = 0; t < 8; ++t) {
            const LAS f32x4* q_kk = (const LAS f32x4*)(Lkk + t * 64); const LAS f32x4* q_w = (const LAS f32x4*)(Lwd + t * 64); const LAS f32x4* q_b = (const LAS f32x4*)(Lb + t * 64);
            const LAS f32x4* q_k = (const LAS f32x4*)(Lk + t * 64); const LAS f32x4* q_r = (const LAS f32x4*)(Lr + t * 64);
            const float vt = Lv[t * 64 + lane];
            float sa0 = 0.f, sa1 = 0.f;
#pragma unroll
            for (int k4 = 0; k4 < 16; ++k4) { const f32x4 x = q_kk[k4];
                sa0 -= S[4 * k4] * x[0]; sa1 -= S[4 * k4 + 1] * x[1]; sa0 -= S[4 * k4 + 2] * x[2]; sa1 -= S[4 * k4 + 3] * x[3];
            }
            const float sa = sa0 + sa1;
            float y0 = 0.f, y1 = 0.f;
#pragma unroll
            for (int k4 = 0; k4 < 16; ++k4) { const f32x4 w = q_w[k4], bb = q_b[k4], kx = q_k[k4]; f32x4 rr; if (MODE == 3) rr = q_r[k4];
#pragma unroll
                for (int i = 0; i < 4; ++i) { const float sn = (MODE == 2) ? (S[4 * k4 + i] * w[i] + sa * bb[i]) : (S[4 * k4 + i] * w[i] + sa * bb[i] + vt * kx[i]); S[4 * k4 + i] = sn;
                    if (MODE == 3) { if (i & 1) y1 += sn * rr[i]; else y0 += sn * rr[i]; } } }
            if (MODE == 3) { const size_t m = m0 + t; const float y = y0 + y1;
                const float mean = wave_sum(y) * (1.f / 64.f); const float d = y - mean; const float var = wave_sum(d * d) * (1.f / 64.f);
                const float yn = d * (1.0f / sqrtf(var + GN_EPS)) * gn_g + gn_b;
                outB[m * 1536 + c] = (bf16)f2bf((yn + Lrk[t] * vt) * Lg[t * 64 + lane]); }
        }
        LDS_WAIT(); asm volatile("" ::: "memory");
    }
    if (MODE == 1 || MODE == 2) { float* dst = (MODE == 1) ? QS : PM;
#pragma unroll
        for (int k4 = 0; k4 < 16; ++k4) *(f32x4*)(dst + 4 * k4) = (f32x4){S[4 * k4], S[4 * k4 + 1], S[4 * k4 + 2], S[4 * k4 + 3]};
    }
}
constexpr int RL_NA = 0, RL_NB = 8192, RL_NK = 16384, RL_NR = 24576, RL_TA = 32768, RL_TBH = 40960, RL_TKH = 49152, RL_TV = 57344;
constexpr int RL_ARB = 65536, RL_ARK = 73728, RL_T = 81920, RL_TX1 = 90112, RL_TU0 = 98304, RL_TW = 106496, RL_TOT = 114688  , RL_GAM = 116736  ;
constexpr size_t WS_RK = 256 * 1024;
constexpr size_t WS_WH = WS_WIN;
__device__ __forceinline__ int rsw(int row, int col) { return row * 128 + ((((col >> 3) ^ (row & 7)) << 4) | ((col & 7) << 1)); }
__device__ __forceinline__ bf16x8 ldfrag(LAS const unsigned char* base, int row, int col0) { return *(const LAS bf16x8*)(base + rsw(row, col0)); }
__device__ __forceinline__ bf16x8 ldfragp(LAS const unsigned char* base, int row, int cb, int hh) {
    union { v2u q[2]; bf16x8 v; } u; u.q[0] = *(const LAS v2u*)(base + rsw(row, cb + 4 * hh)); u.q[1] = *(const LAS v2u*)(base + rsw(row, cb + 8 + 4 * hh)); return u.v; }
__device__ __forceinline__ bf16x8 accfrag(const f32x16& a, int c) { union { unsigned u[4]; bf16x8 v; } p;
#pragma unroll
    for (int q = 0; q < 4; ++q) p.u[q] = cvtpk(a[8 * c + 2 * q], a[8 * c + 2 * q + 1]);
    return p.v; }
__device__ __forceinline__ void st_acc_T(LAS unsigned char* base, const f32x16& a, int colbase, int rowbase, int lane) {
    const int rr = lane & 31, hh = lane >> 5;
#pragma unroll
    for (int g = 0; g < 4; ++g) { v2u w; w.x = cvtpk(a[4 * g], a[4 * g + 1]); w.y = cvtpk(a[4 * g + 2], a[4 * g + 3]); *(LAS v2u*)(base + rsw(colbase + rr, rowbase + 8 * g + 4 * hh)) = w; } }
#define MF32(a, b, c) __builtin_amdgcn_mfma_f32_32x32x16_bf16((a), (b), (c), 0, 0, 0)
__device__ __forceinline__ f32x16 zero16() { f32x16 z;
#pragma unroll
    for (int i = 0; i < 16; ++i) z[i] = 0.f;
    return z; }
__device__ __forceinline__ f32x16 mm32(const f32x16& Z, const f32x16& Y, f32x16 D) {
#pragma unroll
    for (int c = 0; c < 2; ++c) D = MF32(accfrag(Z, c), accfrag(Y, c), D);
    return D; }
__device__ __forceinline__ f32x16 nat_tile(LAS const unsigned char* X, int xt, LAS const unsigned char* Y, int yt, int rr, int hh) { f32x16 d = zero16();
#pragma unroll
    for (int ks = 0; ks < 4; ++ks) d = MF32(ldfrag(X, 32 * xt + rr, 16 * ks + 8 * hh), ldfrag(Y, 32 * yt + rr, 16 * ks + 8 * hh), d);
    return d; }
template <bool STRICT> __device__ __forceinline__ void mask_rc(f32x16& a, int rowbase, int colbase, int rr, int hh) {
#pragma unroll
    for (int i = 0; i < 16; ++i) { const int row = rowbase + (i & 3) + 8 * (i >> 2) + 4 * hh, col = colbase + rr; const bool keep = STRICT ? (row < col) : (row <= col); if (!keep) a[i] = 0.f; } }
__device__ __forceinline__ void inv32(f32x16 P, f32x16 Pt, f32x16& Tm, f32x16& Tmt, int rr, int hh) {
    Tm = P; Tmt = Pt;
#pragma unroll
    for (int i = 0; i < 16; ++i) { const int row = (i & 3) + 8 * (i >> 2) + 4 * hh; if (row == rr) { Tm[i] += 1.0f; Tmt[i] += 1.0f; } }
#pragma unroll 1
    for (int j = 0; j < 4; ++j) {
        const f32x16 P2 = mm32(Pt, P, zero16()), P2t = mm32(P, Pt, zero16());
        P = P2; Pt = P2t;
        const f32x16 Tn = mm32(Tmt, P, Tm), Tnt = mm32(P, Tmt, Tmt);
        Tm = Tn; Tmt = Tnt;
    }
}
__device__ __forceinline__ void rwkv_p1m(const Frame& F, int l, int unit) {
    const int bh = unit >> 7, ch = unit & 127, b = bh >> 3, h = bh & 7, w = F.wave;
    int lane = F.lane; asm volatile("" : "+v"(lane));
    int rr = lane & 31, hh = lane >> 5; const int c = h * 64 + lane;
#define RELANE() do { asm volatile("" : "+v"(lane)); rr = lane & 31; hh = lane >> 5; } while (0)
    LAS unsigned char* L = F.lds;
    LAS float* TOT = (LAS float*)(L + RL_TOT); LAS float* GAM = (LAS float*)(L + RL_GAM);
    const bf16* P = (const bf16*)(F.ws + WS_P);
    const size_t mc = (size_t)b * SEQ + ch * CH;
    {
        const bf16* rw_lw = (const bf16*)(F.ws + WS_RW); const bf16* rw_a = rw_lw + (size_t)M * 512;
        const float* mu = F.in[I_RMU] + l * 1792;
        const float mu_r = mu[c], mu_k = mu[512 + c], mu_v = mu[1024 + c];
        const float k_k = F.in[I_RKK][l * 512 + c], k_a = F.in[I_RKA][l * 512 + c], r_k = F.in[I_RRK][l * 512 + c];
        const size_t m0 = mc + 8 * w;
        float pre = 0.f, tot = 0.f;
        { bf16 raw[64];
#pragma unroll
          for (int t = 0; t < 64; ++t) raw[t] = rw_lw[(mc + t) * 512 + c];
#pragma unroll
          for (int t = 0; t < 64; ++t) { const float x = bf2f(raw[t]); tot += x; if (t < 8 * w) pre += x; } }
        if (w == 0) GAM[lane] = __expf(tot);
        const bool none = (w == 0) && (ch == 0);
        float pr = 0.f, pk = 0.f, pvv = 0.f;
        if (!none) { const bf16* pp = P + (m0 - 1) * NP; pr = bf2f(pp[C_RR + c]); pk = bf2f(pp[C_RK + c]); pvv = bf2f(pp[C_RV + c]); }
        unsigned pa[4], pbh[4], pkh[4], pv[4];
        float cs = pre;
        bf16 rcr[8], rck[8], rcv[8], rlw[8], rav[8];
#pragma unroll
        for (int t = 0; t < 8; ++t) { const bf16* pp = P + (m0 + t) * NP; rcr[t] = pp[C_RR + c]; rck[t] = pp[C_RK + c]; rcv[t] = pp[C_RV + c]; rlw[t] = rw_lw[(m0 + t) * 512 + c]; rav[t] = rw_a[(m0 + t) * 512 + c]; }
#pragma unroll
        for (int t = 0; t < 8; ++t) { const int row = 8 * w + t;
            const float cr = bf2f(rcr[t]), ck = bf2f(rck[t]), cv = bf2f(rcv[t]), lwt = bf2f(rlw[t]), av = bf2f(rav[t]);
            const float k = ck + (pk - ck) * mu_k, vsh = cv + (pvv - cv) * mu_v, rsh = cr + (pr - cr) * mu_r; pk = ck; pvv = cv; pr = cr;
            const float kkv = k * k_k; const float n2 = wave_sum(kkv * kkv); const float kk = kkv / fmaxf(sqrtf(n2), 1e-12f);
            const float kp = k * (1.0f + (av - 1.0f) * k_a), bb = kk * av;
            const float rk = wave_sum(rsh * kp * r_k); if (lane == 0) ((float*)(F.ws + WS_RK))[(size_t)unit * 64 + row] = rk;
            const float csp = cs; cs += lwt;
            const float ecs = __expf(cs), encs = __expf(-cs), ecp = __expf(csp), eL = __expf(tot - cs);
            const float xa = -kk * ecp, xb = bb * encs, xk = kp * encs, xr = rsh * ecs, xbh = bb * eL, xkh = kp * eL;
            const int off = rsw(row, lane);
            const unsigned ha = cvtpk(xa, 0.f) & 0xffffu, hb = cvtpk(xbh, 0.f) & 0xffffu, hk = cvtpk(xkh, 0.f) & 0xffffu, hv = cvtpk(vsh, 0.f) & 0xffffu;
            *(LAS bf16*)(L + RL_NA + off) = (bf16)ha; *(LAS bf16*)(L + RL_NB + off) = (bf16)(cvtpk(xb, 0.f) & 0xffffu);
            *(LAS bf16*)(L + RL_NK + off) = (bf16)(cvtpk(xk, 0.f) & 0xffffu); *(LAS bf16*)(L + RL_NR + off) = (bf16)(cvtpk(xr, 0.f) & 0xffffu);
            if (t & 1) { pa[t >> 1] |= ha << 16; pbh[t >> 1] |= hb << 16; pkh[t >> 1] |= hk << 16; pv[t >> 1] |= hv << 16; } else { pa[t >> 1] = ha; pbh[t >> 1] = hb; pkh[t >> 1] = hk; pv[t >> 1] = hv; }
            }
        const int toff = rsw(lane, 8 * w);
        *(LAS v4u*)(L + RL_TA + toff) = (v4u){pa[0], pa[1], pa[2], pa[3]}; *(LAS v4u*)(L + RL_TBH + toff) = (v4u){pbh[0], pbh[1], pbh[2], pbh[3]};
        *(LAS v4u*)(L + RL_TKH + toff) = (v4u){pkh[0], pkh[1], pkh[2], pkh[3]}; *(LAS v4u*)(L + RL_TV + toff) = (v4u){pv[0], pv[1], pv[2], pv[3]};
    }
    __syncthreads();
    RELANE();
    f32x16 M1 = zero16();
    if (w == 0 || w == 1) {
        const int blk = w;
        f32x16 Nn = nat_tile(L + RL_NA, blk, L + RL_NB, blk, rr, hh);
        f32x16 Nt = nat_tile(L + RL_NB, blk, L + RL_NA, blk, rr, hh);
#pragma unroll
        for (int i = 0; i < 16; ++i) { const int row = (i & 3) + 8 * (i >> 2) + 4 * hh; if (!(rr < row)) Nn[i] = 0.f; if (!(row < rr)) Nt[i] = 0.f; }
        f32x16 Tm, Tmt; inv32(Nn, Nt, Tm, Tmt, rr, hh);
        st_acc_T(L + RL_T, Tmt, 32 * blk, 32 * blk, lane);
        if (w == 0) { const f32x16 N21t = nat_tile(L + RL_NB, 0, L + RL_NA, 1, rr, hh); M1 = mm32(N21t, Tm, zero16()); }
    } else if (w <= 4) {
        const int tau = (w == 2) ? 0 : 1, vt0 = (w == 2) ? 0 : (w - 3), nvt = (w == 2) ? 2 : 1;
        f32x16 x1[2]; x1[0] = zero16(); x1[1] = zero16();
#pragma unroll 1
        for (int sg = 0; sg <= tau; ++sg) {
            f32x16 ak = nat_tile(L + RL_NK, sg, L + RL_NA, tau, rr, hh);
            if (sg == tau) mask_rc<true>(ak, 0, 0, rr, hh);
#pragma unroll
            for (int cc = 0; cc < 2; ++cc) { const bf16x8 af = accfrag(ak, cc);
#pragma unroll
                for (int j = 0; j < 2; ++j) if (j < nvt) x1[j] = MF32(af, ldfragp(L + RL_TV, 32 * (vt0 + j) + rr, 32 * sg + 16 * cc, hh), x1[j]); }
        }
#pragma unroll
        for (int j = 0; j < 2; ++j) if (j < nvt) st_acc_T(L + RL_TX1, x1[j], 32 * (vt0 + j), 32 * tau, lane);
    } else {
#pragma unroll 1
        for (int q = 0; q < 2; ++q) { const int id = (w - 5) * 2 + q;
            const int isb = id >= 3, tq = isb ? id - 3 : id; const int sg = (tq == 2) ? 1 : 0, tau = (tq == 0) ? 0 : 1;
            f32x16 a = nat_tile(isb ? (L + RL_NB) : (L + RL_NK), sg, L + RL_NR, tau, rr, hh);
            if (sg == tau) mask_rc<false>(a, 0, 0, rr, hh);
            st_acc_T(isb ? (L + RL_ARB) : (L + RL_ARK), a, 32 * tau, 32 * sg, lane); }
    }
    __syncthreads();
    RELANE();
    if (w == 0) {
        f32x16 t21 = zero16();
#pragma unroll
        for (int cc = 0; cc < 2; ++cc) t21 = MF32(ldfragp(L + RL_T, 32 + rr, 32 + 16 * cc, hh), accfrag(M1, cc), t21);
#pragma unroll
        for (int i = 0; i < 16; ++i) { const int row = 32 + (i & 3) + 8 * (i >> 2) + 4 * hh; *(LAS bf16*)(L + RL_T + rsw(row, rr)) = (bf16)(cvtpk(t21[i], 0.f) & 0xffffu); }
    }
    __syncthreads();
    RELANE();
    {
        const int tau = (w >> 1) & 1, ct = w & 1; LAS const unsigned char* Bimg = (w < 4) ? (L + RL_TA) : (L + RL_TX1);
        f32x16 d = zero16();
#pragma unroll 1
        for (int cs4 = 0; cs4 < 2 * (tau + 1); ++cs4) d = MF32(ldfrag(L + RL_T, 32 * tau + rr, 16 * cs4 + 8 * hh), ldfrag(Bimg, 32 * ct + rr, 16 * cs4 + 8 * hh), d);
        st_acc_T((w < 4) ? (L + RL_TW) : (L + RL_TU0), d, 32 * ct, 32 * tau, lane);
    }
    __syncthreads();
    RELANE();
    {
        const int rt = (w >> 1) & 1, ct = w & 1;
        if (w < 4) {
            f32x16 pm = zero16();
#pragma unroll
            for (int cs4 = 0; cs4 < 4; ++cs4) pm = MF32(ldfrag(L + RL_TW, 32 * rt + rr, 16 * cs4 + 8 * hh), ldfrag(L + RL_TBH, 32 * ct + rr, 16 * cs4 + 8 * hh), pm);
            float* PMg = (float*)(F.ws + WS_PM) + (size_t)unit * 4096;
            const float gm = GAM[32 * ct + rr];
#pragma unroll
            for (int i = 0; i < 16; ++i) { const int row = (i & 3) + 8 * (i >> 2) + 4 * hh; float x = pm[i]; if (rt == ct && row == rr) x += gm; PMg[(32 * rt + row) * 64 + 32 * ct + rr] = x; }
            f32x16 wh = zero16(); const int tau = ct;
#pragma unroll 1
            for (int cs4 = 0; cs4 < 2 * (tau + 1); ++cs4) wh = MF32(ldfrag(L + RL_TW, 32 * rt + rr, 16 * cs4 + 8 * hh), ldfrag(L + RL_ARB, 32 * tau + rr, 16 * cs4 + 8 * hh), wh);
            bf16* WH = (bf16*)(F.ws + WS_WH) + (size_t)unit * 4096 + (size_t)(32 * tau + rr) * 64;
#pragma unroll
            for (int g = 0; g < 4; ++g) { const int k0 = 32 * rt + 8 * g + 4 * hh; const v2u rw2 = *(const LAS v2u*)(L + RL_NR + rsw(32 * tau + rr, k0));
                v2u o; o.x = cvtpk(wh[4 * g] + __uint_as_float(rw2.x << 16), wh[4 * g + 1] + __uint_as_float(rw2.x & 0xffff0000u)); o.y = cvtpk(wh[4 * g + 2] + __uint_as_float(rw2.y << 16), wh[4 * g + 3] + __uint_as_float(rw2.y & 0xffff0000u));
                *(v2u*)(WH + k0) = o; }
        } else {
            f32x16 qs = zero16();
#pragma unroll
            for (int cs4 = 0; cs4 < 4; ++cs4) { qs = MF32(ldfrag(L + RL_TU0, 32 * rt + rr, 16 * cs4 + 8 * hh), ldfrag(L + RL_TBH, 32 * ct + rr, 16 * cs4 + 8 * hh), qs);
                                                qs = MF32(ldfrag(L + RL_TV, 32 * rt + rr, 16 * cs4 + 8 * hh), ldfrag(L + RL_TKH, 32 * ct + rr, 16 * cs4 + 8 * hh), qs); }
            float* QSg = (float*)(F.ws + WS_QS) + (size_t)unit * 4096;
#pragma unroll
            for (int i = 0; i < 16; ++i) { const int row = (i & 3) + 8 * (i >> 2) + 4 * hh; QSg[(32 * rt + row) * 64 + 32 * ct + rr] = qs[i]; }
            f32x16 y0 = zero16(); const int tau = ct;
#pragma unroll 1
            for (int cs4 = 0; cs4 < 2 * (tau + 1); ++cs4) { y0 = MF32(ldfrag(L + RL_TU0, 32 * rt + rr, 16 * cs4 + 8 * hh), ldfrag(L + RL_ARB, 32 * tau + rr, 16 * cs4 + 8 * hh), y0);
                                                              y0 = MF32(ldfrag(L + RL_TV, 32 * rt + rr, 16 * cs4 + 8 * hh), ldfrag(L + RL_ARK, 32 * tau + rr, 16 * cs4 + 8 * hh), y0); }
            bf16* Y0g = (bf16*)(F.ws + WS_BR) + (mc + 32 * tau + rr) * 1536 + 512 + h * 64;
#pragma unroll
            for (int g = 0; g < 4; ++g) { const int v0 = 32 * rt + 8 * g + 4 * hh; v2u o; o.x = cvtpk(y0[4 * g], y0[4 * g + 1]); o.y = cvtpk(y0[4 * g + 2], y0[4 * g + 3]); *(v2u*)(Y0g + v0) = o; }
        }
    }
    __syncthreads();
#undef RELANE
}

__device__ __forceinline__ void rwkv_p3m(const Frame& F, int l, int unit2) {
    const int unit = unit2 >> 1, tt = unit2 & 1;
    const int bh = unit >> 7, ch = unit & 127, b = bh >> 3, h = bh & 7, lane = F.lane, rr = lane & 31, hh = lane >> 5;
    const size_t m = (size_t)b * SEQ + ch * CH + 32 * tt + rr;
    const float* QS = (const float*)(F.ws + WS_QS) + (size_t)unit * 4096;
    const bf16* WH = (const bf16*)(F.ws + WS_WH) + (size_t)unit * 4096 + (size_t)(32 * tt + rr) * 64 + 8 * hh;
    bf16x8 wf[4];
#pragma unroll
    for (int ks = 0; ks < 4; ++ks) wf[ks] = *(const bf16x8*)(WH + 16 * ks);
    f32x16 acc[2];
#pragma unroll
    for (int vt = 0; vt < 2; ++vt) { acc[vt] = zero16();
#pragma unroll
        for (int ks = 0; ks < 4; ++ks) { const float* sp = QS + (size_t)(32 * vt + rr) * 64 + 16 * ks + 8 * hh; const f32x4 s0 = *(const f32x4*)sp, s1 = *(const f32x4*)(sp + 4);
            union { unsigned u[4]; bf16x8 v; } a; a.u[0] = cvtpk(s0[0], s0[1]); a.u[1] = cvtpk(s0[2], s0[3]); a.u[2] = cvtpk(s1[0], s1[1]); a.u[3] = cvtpk(s1[2], s1[3]);
            acc[vt] = MF32(a.v, wf[ks], acc[vt]); } }
    bf16* ob = (bf16*)(F.ws + WS_BR) + m * 1536 + 512 + h * 64 + 4 * hh;
    float sum = 0.f;
#pragma unroll
    for (int vt = 0; vt < 2; ++vt)
#pragma unroll
        for (int g = 0; g < 4; ++g) { const v2u y0 = *(const v2u*)(ob + 32 * vt + 8 * g);
            acc[vt][4 * g] += __uint_as_float(y0.x << 16); acc[vt][4 * g + 1] += __uint_as_float(y0.x & 0xffff0000u); acc[vt][4 * g + 2] += __uint_as_float(y0.y << 16); acc[vt][4 * g + 3] += __uint_as_float(y0.y & 0xffff0000u);
            sum += (acc[vt][4 * g] + acc[vt][4 * g + 1]) + (acc[vt][4 * g + 2] + acc[vt][4 * g + 3]); }
    sum += __shfl_xor(sum, 32);
    const float mean = sum * (1.f / 64.f); float sq = 0.f;
#pragma unroll
    for (int vt = 0; vt < 2; ++vt)
#pragma unroll
        for (int i = 0; i < 16; ++i) { const float d = acc[vt][i] - mean; acc[vt][i] = d; sq += d * d; }
    sq += __shfl_xor(sq, 32);
    const float rstd = 1.0f / sqrtf(sq * (1.f / 64.f) + GN_EPS);
    const float rk = ((const float*)(F.ws + WS_RK))[(size_t)unit * 64 + 32 * tt + rr];
    const bool first = (ch == 0) && (tt == 0) && (rr == 0);
    const bf16* pv = (const bf16*)(F.ws + WS_P) + m * NP + C_RV + h * 64 + 4 * hh;
    const bf16* gp = (const bf16*)(F.ws + WS_RW) + (size_t)2 * M * 512 + m * 512 + h * 64 + 4 * hh;
    const float* gng = F.in[I_RGNG] + l * 512 + h * 64 + 4 * hh; const float* gnb = F.in[I_RGNB] + l * 512 + h * 64 + 4 * hh; const float* muv = F.in[I_RMU] + l * 1792 + 1024 + h * 64 + 4 * hh;
#pragma unroll
    for (int vt = 0; vt < 2; ++vt)
#pragma unroll
        for (int g = 0; g < 4; ++g) { const int v0 = 32 * vt + 8 * g;
            const v2u cw = *(const v2u*)(pv + v0); v2u pw = (v2u){0u, 0u}; if (!first) pw = *(const v2u*)(pv - NP + v0);
            const v2u gw = *(const v2u*)(gp + v0);
            const f32x4 g4 = *(const f32x4*)(gng + v0), b4 = *(const f32x4*)(gnb + v0), m4 = *(const f32x4*)(muv + v0);
            float o[4];
#pragma unroll
            for (int i = 0; i < 4; ++i) { const unsigned cwi = (i < 2) ? cw.x : cw.y, pwi = (i < 2) ? pw.x : pw.y, gwi = (i < 2) ? gw.x : gw.y;
                const float cv = (i & 1) ? __uint_as_float(cwi & 0xffff0000u) : __uint_as_float(cwi << 16), pvv = (i & 1) ? __uint_as_float(pwi & 0xffff0000u) : __uint_as_float(pwi << 16);
                const float gg = (i & 1) ? __uint_as_float(gwi & 0xffff0000u) : __uint_as_float(gwi << 16);
                const float vsh = cv + (pvv - cv) * m4[i];
                o[i] = (acc[vt][4 * g + i] * rstd * g4[i] + b4[i] + rk * vsh) * gg; }
            v2u w; w.x = cvtpk(o[0], o[1]); w.y = cvtpk(o[2], o[3]); *(v2u*)(ob + v0) = w; }
}
__device__ __forceinline__ void rwkv_p2_wave(const Frame& F, int row, LAS float* Ls) {
    const int bh = row >> 6, v = row & 63, lane = F.lane;
    const float* PM = (const float*)(F.ws + WS_PM) + (size_t)bh * NCH * 4096 + lane; float* QS = (float*)(F.ws + WS_QS) + (size_t)bh * NCH * 4096 + v * 64 + lane;
    float s = 0.f;
    float pa[64];
#pragma unroll
    for (int k = 0; k < 64; ++k) pa[k] = PM[k * 64];
#pragma unroll 1
    for (int cc = 0; cc < NCH; ++cc) {
        const float q = QS[(size_t)cc * 4096];
        QS[(size_t)cc * 4096] = s;
        Ls[lane] = s;
        float pb[64]; const float* PMn = PM + (size_t)((cc + 1 < NCH) ? cc + 1 : cc) * 4096;
#pragma unroll
        for (int k = 0; k < 64; ++k) pb[k] = PMn[k * 64];
        LDS_WAIT(); asm volatile("" ::: "memory");
        float a0 = q, a1 = 0.f, a2 = 0.f, a3 = 0.f;
#pragma unroll
        for (int k4 = 0; k4 < 16; ++k4) { const f32x4 x = *(const LAS f32x4*)(Ls + 4 * k4); a0 += x[0] * pa[4 * k4]; a1 += x[1] * pa[4 * k4 + 1]; a2 += x[2] * pa[4 * k4 + 2]; a3 += x[3] * pa[4 * k4 + 3]; }
        s = (a0 + a1) + (a2 + a3);
#pragma unroll
        for (int k = 0; k < 64; ++k) pa[k] = pb[k];
        LDS_WAIT(); asm volatile("" ::: "memory");
    }
}

constexpr int PPL = 11;
constexpr int N_PHASES = 2 + PPL * DEPTH;
#ifndef REP_ID
#define REP_ID -1
#endif
#ifndef REP_N
#define REP_N 1
#endif
#define REPF(id) for (int rep_ = 0; rep_ < ((id) == REP_ID ? REP_N : 1); ++rep_)
#define REPT(id, ...) do { __VA_ARGS__; if ((id) == REP_ID) { __VA_ARGS__; __VA_ARGS__; } } while (0)
#ifndef NEW_ATT
#define NEW_ATT 1
#endif
#ifndef NEW_GLA
#define NEW_GLA 3
#endif
#ifndef NEW_RWKV
#define NEW_RWKV 3
#endif
__global__ void __launch_bounds__(NTHR, 2) mk_fwd(Args args) {
    extern __shared__ __attribute__((aligned(16))) unsigned char lds_raw[];
    Frame F;
    F.lds = (LAS unsigned char*)lds_raw; F.tid = threadIdx.x; F.lane = F.tid & 63; F.wave = __builtin_amdgcn_readfirstlane(F.tid >> 6);
    F.bid = blockIdx.x; F.G = gridDim.x; F.in = args.in; F.out = args.out; F.ws = args.ws;
    volatile LAS unsigned* MISC = (volatile LAS unsigned*)(F.lds + MISC_OFF);
    if (F.tid < 32) MISC[F.tid] = 0u;
    __syncthreads();
    const int lo = args.ph_lo, hi = args.ph_hi;
    XcdBarrier bar; bar.bar = (unsigned*)(F.ws + WS_CTL) + CW_BAR; bar.x = 0; bar.st = nullptr;
    if (hi - lo > 1) bar = xcd_barrier_post((unsigned*)(F.ws + WS_CTL) + CW_BAR, MISC + 8);
#define IN(k) (lo <= (k) && (k) < hi)
#ifndef EN_MASK
#define EN_MASK 0xFFF
#endif
#define EN(i) ((EN_MASK >> (i)) & 1)
#define SEAM(k) do { if (IN(k) && IN((k) + 1)) xcd_barrier(bar, F.wave); } while (0)
#define PHASE_PTRS() Frame Fl = F; Fl.ws = launder(F.ws); Fl.out = launder(F.out); { int ln_ = (int)__builtin_amdgcn_mbcnt_hi(~0u, __builtin_amdgcn_mbcnt_lo(~0u, 0u)); asm volatile("" : "+v"(ln_)); int wv_ = F.wave, bd_ = F.bid; asm volatile("" : "+s"(wv_), "+s"(bd_)); Fl.lane = ln_; Fl.wave = wv_; Fl.bid = bd_; Fl.tid = wv_ * 64 + ln_; } \
    const float* mod = (const float*)(Fl.ws + WS_MOD); bf16* P = (bf16*)(Fl.ws + WS_P); bf16* UB = (bf16*)(Fl.ws + WS_UB); bf16* BR = (bf16*)(Fl.ws + WS_BR); \
    float* H = (float*)(Fl.ws + WS_H); bf16* HID = (bf16*)(Fl.ws + WS_HID); (void)mod; (void)P; (void)UB; (void)BR; (void)H; (void)HID;
    if (IN(0) && EN(0)) { phase_mod(F); } SEAM(0);
    if (IN(1) && EN(1)) { convert_weights(F, 0); make_u0(F); } SEAM(1);
#pragma unroll 1
    for (int l = 0; l < DEPTH; ++l) {
        const int pb = 2 + PPL * l;
        if (IN(pb + 0) && EN(2)) { PHASE_PTRS(); pg8::Gemm g{UB, (const bf16*)(Fl.ws + WS_WIN), M, NP, D}; pg8::StaticOrder S; S.init(M, NP, F.G, Fl.bid);
            pg8::EpiBf16<0> E{P, NP, nullptr, 0, 0, 1.f};
            REPF(0) pg8::gemm_phase<pg8::EpiBf16<0>, pg8::StaticOrder, true, true>(F.lds, g, S, E, Fl.wave); }
        SEAM(pb + 0);
        if (IN(pb + 1) && EN(3)) { PHASE_PTRS(); REPF(1) for (int u = Fl.bid * NWAVES + Fl.wave; u < 2048; u += F.G * NWAVES) rwprep_unit(Fl, l, u);
#if NEW_ATT == 1
            { LAS float* Lw = (LAS float*)(F.lds + Fl.wave * 16384);
              REPF(2) for (int u = Fl.bid * NWAVES + Fl.wave; u < 4096; u += F.G * NWAVES) attn_unit(Fl, 0, u, (LAS bf16*)Lw); }
#endif
        }
        SEAM(pb + 1);
        if (IN(pb + 2) && EN(4)) { PHASE_PTRS(); LAS float* Lw = (LAS float*)(F.lds + Fl.wave * 16384);
            __syncthreads();
            const int gw = Fl.bid * NWAVES + Fl.wave, NGW = F.G * NWAVES;
            if (NEW_RWKV == 3) { REPT(3, for (int u = Fl.bid; u < 2048; u += F.G) rwkv_p1m(Fl, l, u)); }
            if (NEW_RWKV == 1) { REPF(3) for (int u = gw; u < 2048; u += NGW) rwkv_chunk<1>(Fl, l, u, Lw); }
            if (NEW_RWKV == 1) { REPF(4) for (int u = gw; u < 2048; u += NGW) rwkv_chunk<2>(Fl, l, u, Lw); }
            if (NEW_GLA == 1) { REPF(5) for (int u = gw; u < 1024; u += NGW) gla_chunk<1>(Fl, l, u, Lw); }
            if (NEW_GLA == 3) { REPT(5, for (int u = (gw + 512) % NGW; u < 1024; u += NGW) gla_p1m(Fl, l, u, Lw)); }
            if (NEW_ATT == 1) { for (int u = (gw + 1024) % NGW; u < 4096; u += NGW) attn_unit(Fl, 1, u, (LAS bf16*)Lw); }
            __syncthreads();
        }
        SEAM(pb + 2);
        if (IN(pb + 3) && EN(5)) { PHASE_PTRS(); LAS float* Lw = (LAS float*)(F.lds + Fl.wave * 16384);
            if (Fl.bid < 128) { if (NEW_RWKV == 1 || NEW_RWKV == 3) rwkv_p2_wave(Fl, Fl.bid * NWAVES + Fl.wave, Lw); }
            else { if (NEW_GLA == 1 || NEW_GLA == 3) gla_p2(Fl, (Fl.bid - 128) * NTHR + Fl.tid);
                   if (NEW_ATT == 1) for (int u = (Fl.bid - 128) * NWAVES + Fl.wave; u < 4096; u += 128 * NWAVES) attn_unit(Fl, 2, u, (LAS bf16*)Lw); }
            __syncthreads();
        }
        SEAM(pb + 3);
        if (IN(pb + 4) && EN(5)) { PHASE_PTRS(); LAS float* Lw = (LAS float*)(F.lds + Fl.wave * 16384);
            const int gw = Fl.bid * NWAVES + Fl.wave, NGW = F.G * NWAVES;
            if (NEW_RWKV == 1) { REPF(7) for (int u = gw; u < 2048; u += NGW) rwkv_chunk<3>(Fl, l, u, Lw); }
            if (NEW_RWKV == 3) { for (int u = gw; u < 4096; u += NGW) rwkv_p3m(Fl, l, u); }
            if (NEW_GLA == 1) { REPF(8) for (int u = gw; u < 1024; u += NGW) gla_chunk<3>(Fl, l, u, Lw); }
            if (NEW_GLA == 3) { REPT(8, for (int u = gw; u < 2048; u += NGW) gla_p3m(Fl, l, u, (LAS unsigned char*)Lw)); }
            __syncthreads();
        }
        SEAM(pb + 4);
        if (IN(pb + 5) && EN(6)) { PHASE_PTRS(); pg8::Gemm g{BR, (const bf16*)(Fl.ws + WS_WBR), M, D, 1536}; pg8::StaticOrder S; S.init(M, D, F.G, Fl.bid);
            pg8::EpiBranchK E{P + C_GATE, NP, UB};
            REPF(9) pg8::gemm_phase<pg8::EpiBranchK, pg8::StaticOrder, false, true>(F.lds, g, S, E, Fl.wave); }
        SEAM(pb + 5);
        if (IN(pb + 6) && EN(7)) { PHASE_PTRS(); pg8::Gemm g{UB, (const bf16*)(Fl.ws + WS_WOUT), M, D, D}; pg8::StaticOrder S; S.init(M, D, F.G, Fl.bid);
            pg8::EpiF32 E{H, D};
            REPF(10) pg8::gemm_phase<pg8::EpiF32, pg8::StaticOrder, false, true>(F.lds, g, S, E, Fl.wave); }
        SEAM(pb + 6);
        if (IN(pb + 7) && EN(8)) { PHASE_PTRS(); const float* xold = (l == 0) ? launder(F.in[I_X]) : (const float*)Fl.out;
            phase_ln(Fl, xold, H, mod + (size_t)l * 2 * 6144 + 2 * 1024, launder(F.in[I_LN1G]) + l * D, launder(F.in[I_LN1B]) + l * D, Fl.out, mod + (size_t)l * 2 * 6144 + 3 * 1024, UB); }
        SEAM(pb + 7);
        if (IN(pb + 8) && EN(9)) { PHASE_PTRS(); pg8::Gemm g{UB, (const bf16*)(Fl.ws + WS_W1), M, 2 * FFH, D}; pg8::StaticOrder S; S.init(M, 2 * FFH, F.G, Fl.bid);
            pg8::EpiSwiglu E{HID, FFH};
            REPF(11) pg8::gemm_phase<pg8::EpiSwiglu, pg8::StaticOrder, true, true>(F.lds, g, S, E, Fl.wave); }
        SEAM(pb + 8);
        if (IN(pb + 9) && EN(10)) { PHASE_PTRS(); pg8::Gemm g{HID, (const bf16*)(Fl.ws + WS_W2), M, D, FFH}; pg8::StaticOrder S; S.init(M, D, F.G, Fl.bid);
            pg8::EpiF32 E{H, D};
            REPF(12) pg8::gemm_phase<pg8::EpiF32, pg8::StaticOrder, false, true>(F.lds, g, S, E, Fl.wave); }
        SEAM(pb + 9);
        if (IN(pb + 10) && EN(11)) { PHASE_PTRS();
            const float* nsh = (l + 1 < DEPTH) ? mod + (size_t)(l + 1) * 2 * 6144 : nullptr;
            phase_ln(Fl, Fl.out, H, mod + (size_t)l * 2 * 6144 + 5 * 1024, launder(F.in[I_LN2G]) + l * D, launder(F.in[I_LN2B]) + l * D, Fl.out, nsh, UB);
            if (l + 1 < DEPTH) convert_weights(Fl, l + 1);
        }
        SEAM(pb + 10);
    }
#undef IN
#undef SEAM
}

extern "C" void kernel_launch(void* const* d_in, const int* in_sizes, int n_in, void* d_out, int out_size, void* d_ws, size_t ws_size, hipStream_t stream) {
    static int grid = 0;
    if (grid == 0) {
        if (n_in != N_IN || in_sizes[0] != M * D || out_size != M * D || ws_size < WS_END) { fprintf(stderr, "kernel_launch: unexpected shapes (n_in %d, in0 %d, out %d, ws %zu, need %zu)\n", n_in, n_in > 0 ? in_sizes[0] : -1, out_size, ws_size, (size_t)WS_END); grid = -1; return; }
        int dev = 0, cus = 0, per_cu = 0;
        if (hipGetDevice(&dev) != hipSuccess || hipDeviceGetAttribute(&cus, hipDeviceAttributeMultiprocessorCount, dev) != hipSuccess) { grid = -1; return; }
        if (hipFuncSetAttribute((const void*)mk_fwd, hipFuncAttributeMaxDynamicSharedMemorySize, LDS_BYTES) != hipSuccess) { fprintf(stderr, "kernel_launch: hipFuncSetAttribute failed\n"); grid = -1; return; }
        if (hipOccupancyMaxActiveBlocksPerMultiprocessor(&per_cu, (const void*)mk_fwd, NTHR, LDS_BYTES) != hipSuccess || per_cu < 1) fprintf(stderr, "kernel_launch: occupancy query says %d\n", per_cu);
        (void)hipGetLastError();
        grid = 256;
        if (cus < 256) { fprintf(stderr, "kernel_launch: %d CUs < 256\n", cus); grid = -1; return; }
    }
    if (grid < 0) return;
    (void)hipMemsetAsync((char*)d_ws + WS_CTL, 0, CTL_ZERO_BYTES, stream);
    Args a{};
    for (int i = 0; i < N_IN; ++i) a.in[i] = (const float*)d_in[i];
    a.out = (float*)d_out; a.ws = (unsigned char*)d_ws;
#if MK_ONE_LAUNCH
    a.ph_lo = 0; a.ph_hi = N_PHASES;
    hipLaunchKernelGGL(mk_fwd, dim3(grid), dim3(NTHR), LDS_BYTES, stream, a);
#else
    for (int k = 0; k < N_PHASES; ++k) { a.ph_lo = k; a.ph_hi = k + 1; hipLaunchKernelGGL(mk_fwd, dim3(grid), dim3(NTHR), LDS_BYTES, stream, a); }
#endif
}
```
